# Optimizing an MI355X kernel written in HIP

```python
import math
import jax, jax.numpy as jnp
from jax import lax
import numpy as np


D_MODEL = 1024
BATCH = 4
SEQ = 8192
DEPTH = 2

CHUNK = 64
Q_BLOCK = 128
HEAD_DIM = 64
N_BRANCHES = 4
BRANCH_WIDTH = 4 * HEAD_DIM

DIFF_HEADS = 4
DIFF_DH = HEAD_DIM // 2

CHUNK_HEADS = 4
BAND_PREV = 8
REL_CLIP = 128

MLA_HEADS = 4
MLA_Q_LORA = D_MODEL // 4
MLA_KV_LORA = D_MODEL // 8
MLA_NOPE = HEAD_DIM
MLA_ROPE = HEAD_DIM // 2
MLA_V = HEAD_DIM
ROPE_BASE = 10000.0

FOX_HEADS = 4

T5_BUCKETS = 32
T5_MAX_DIST = 128

N_GROUPS = 4
EXPERTS_PER_GROUP = 8
N_EXPERTS = N_GROUPS * EXPERTS_PER_GROUP
TOP_K = 2
D_EXPERT = D_MODEL // 2
MOE_BLOCK = 256

DEEPNORM_ALPHA = (2 * DEPTH) ** 0.25
DEEPNORM_BETA = (8 * DEPTH) ** -0.25
NORM_EPS = 1e-5
NEG_INF = -1e30

IN_SPLITS = (
    DIFF_HEADS * HEAD_DIM, DIFF_HEADS * HEAD_DIM, DIFF_HEADS * HEAD_DIM,
    CHUNK_HEADS * HEAD_DIM, CHUNK_HEADS * HEAD_DIM, CHUNK_HEADS * HEAD_DIM,
    MLA_Q_LORA, MLA_KV_LORA, MLA_ROPE,
    FOX_HEADS * HEAD_DIM, FOX_HEADS * HEAD_DIM, FOX_HEADS * HEAD_DIM, FOX_HEADS,
)
IN_OFFSETS = tuple(int(o) for o in np.cumsum(IN_SPLITS)[:-1])
D_IN = sum(IN_SPLITS)

kernel_name = 'hybrid_chunk_causal_moe_trunk'


def layer_norm(x, g, b):
    xf = x.astype(jnp.float32)
    mu = jnp.mean(xf, axis=-1, keepdims=True)
    var = jnp.mean(jnp.square(xf - mu), axis=-1, keepdims=True)
    return ((xf - mu) * lax.rsqrt(var + NORM_EPS)).astype(x.dtype) * g + b


def rms_norm(x, g):
    xf = x.astype(jnp.float32)
    return (xf * lax.rsqrt(jnp.mean(xf * xf, axis=-1, keepdims=True) + NORM_EPS)).astype(x.dtype) * g


def apply_rope(x, cos, sin):
    x1, x2 = jnp.split(x, 2, axis=-1)
    c = cos[:, None, :].astype(x.dtype)
    s = sin[:, None, :].astype(x.dtype)
    return jnp.concatenate([x1 * c - x2 * s, x1 * s + x2 * c], axis=-1)


def chunk_causal_mask(q_pos, k_pos):
    return (k_pos[None, :] // CHUNK) <= (q_pos[:, None] // CHUNK)


def t5_bucket(rel):
    nb = T5_BUCKETS // 2
    max_exact = nb // 2
    ret = jnp.where(rel > 0, nb, 0)
    n = jnp.abs(rel)
    nf = jnp.maximum(n, 1).astype(jnp.float32)
    large = max_exact + (jnp.log(nf / max_exact) / math.log(T5_MAX_DIST / max_exact) * (nb - max_exact)).astype(jnp.int32)
    large = jnp.minimum(large, nb - 1)
    return ret + jnp.where(n < max_exact, n, large)


def t5_bias(q_pos, k_pos, table):
    rel = k_pos[None, :] - q_pos[:, None]
    return jnp.moveaxis(table[t5_bucket(rel)], -1, 0).astype(jnp.float32)


def sweep_query_blocks(block_fn, *q_side):
    b, s = q_side[0].shape[:2]
    n_blk = s // Q_BLOCK
    def split(a):
        return jnp.moveaxis(a.reshape((b, n_blk, Q_BLOCK) + a.shape[2:]), 1, 0)
    out = lax.map(lambda args: block_fn(*args), (jnp.arange(n_blk),) + tuple(split(a) for a in q_side))
    out = jnp.moveaxis(out, 0, 1)
    return out.reshape((b, s) + out.shape[3:])


def differential_attention(q, k, v, lam, norm_g, t5_table, layer_idx):
    b, s = q.shape[:2]
    lambda_init = 0.8 - 0.6 * math.exp(-0.3 * layer_idx)
    lamf = lam.astype(jnp.float32)
    lam_full = jnp.exp(jnp.sum(lamf[0] * lamf[1])) - jnp.exp(jnp.sum(lamf[2] * lamf[3])) + lambda_init
    k_pos = jnp.arange(s)
    scale = DIFF_DH ** -0.5

    def block(blk, qb):
        q_pos = blk * Q_BLOCK + jnp.arange(Q_BLOCK)
        logits = jnp.einsum('bqhcd,bkhcd->bchqk', qb, k, preferred_element_type=jnp.float32) * scale
        logits = logits + t5_bias(q_pos, k_pos, t5_table)
        logits = jnp.where(chunk_causal_mask(q_pos, k_pos), logits, NEG_INF)
        p = jax.nn.softmax(logits, axis=-1)
        attn = (p[:, 0] - lam_full * p[:, 1]).astype(v.dtype)
        return jnp.einsum('bhqk,bkhe->bqhe', attn, v)

    o = sweep_query_blocks(block, q)
    o = rms_norm(o, norm_g) * (1.0 - lambda_init)
    return o.reshape(b, s, -1)


def chunk_band_attention(q, k, v, rel_table):
    b, s, h, dh = q.shape
    nc = s // CHUNK
    band = (BAND_PREV + 1) * CHUNK
    qc = q.reshape(b, nc, CHUNK, h, dh)

    def gather_band(a):
        ac = jnp.pad(a.reshape(b, nc, CHUNK, h, dh), ((0, 0), (BAND_PREV, 0), (0, 0), (0, 0), (0, 0)))
        return jnp.concatenate([ac[:, j:j + nc] for j in range(BAND_PREV + 1)], axis=2)

    kb, vb = gather_band(k), gather_band(v)
    logits = jnp.einsum('bnqhd,bnkhd->bnhqk', qc, kb, preferred_element_type=jnp.float32) * dh ** -0.5
    key_off = jnp.arange(band) - BAND_PREV * CHUNK
    rel = key_off[None, :] - jnp.arange(CHUNK)[:, None]
    bias = rel_table[jnp.clip(rel, -REL_CLIP, REL_CLIP) + REL_CLIP]
    logits = logits + jnp.moveaxis(bias, -1, 0).astype(jnp.float32)
    key_chunk = jnp.arange(nc)[:, None] + jnp.arange(BAND_PREV + 1)[None, :] - BAND_PREV
    valid = jnp.repeat(key_chunk >= 0, CHUNK, axis=1)
    logits = jnp.where(valid[None, :, None, None, :], logits, NEG_INF)
    p = jax.nn.softmax(logits, axis=-1).astype(v.dtype)
    o = jnp.einsum('bnhqk,bnkhd->bnqhd', p, vb)
    return o.reshape(b, s, h * dh)


def latent_attention(c_q, c_kv, k_rope, q_norm_g, kv_norm_g, w_uq, w_ukv, cos, sin):
    b, s, _ = c_q.shape
    q = (rms_norm(c_q, q_norm_g) @ w_uq).reshape(b, s, MLA_HEADS, MLA_NOPE + MLA_ROPE)
    kv = (rms_norm(c_kv, kv_norm_g) @ w_ukv).reshape(b, s, MLA_HEADS, MLA_NOPE + MLA_V)
    q = jnp.concatenate([q[..., :MLA_NOPE], apply_rope(q[..., MLA_NOPE:], cos, sin)], axis=-1)
    k_r = jnp.broadcast_to(apply_rope(k_rope[:, :, None, :], cos, sin), (b, s, MLA_HEADS, MLA_ROPE))
    k = jnp.concatenate([kv[..., :MLA_NOPE], k_r], axis=-1)
    v = kv[..., MLA_NOPE:]
    k_pos = jnp.arange(s)
    scale = (MLA_NOPE + MLA_ROPE) ** -0.5

    def block(blk, qb):
        q_pos = blk * Q_BLOCK + jnp.arange(Q_BLOCK)
        logits = jnp.einsum('bqhd,bkhd->bhqk', qb, k, preferred_element_type=jnp.float32) * scale
        logits = jnp.where(chunk_causal_mask(q_pos, k_pos), logits, NEG_INF)
        p = jax.nn.softmax(logits, axis=-1).astype(v.dtype)
        return jnp.einsum('bhqk,bkhe->bqhe', p, v)

    return sweep_query_blocks(block, q).reshape(b, s, -1)


def forgetting_attention(q, k, v, f_logit):
    b, s, h, dh = q.shape
    cum = jnp.cumsum(jax.nn.log_sigmoid(f_logit.astype(jnp.float32)), axis=1)
    cum_k = jnp.moveaxis(cum, 1, 2)
    k_pos = jnp.arange(s)
    scale = dh ** -0.5

    def block(blk, qb, cum_q):
        q_pos = blk * Q_BLOCK + jnp.arange(Q_BLOCK)
        logits = jnp.einsum('bqhd,bkhd->bhqk', qb, k, preferred_element_type=jnp.float32) * scale
        logits = logits + jnp.moveaxis(cum_q, 1, 2)[..., None] - cum_k[:, :, None, :]
        logits = jnp.where(k_pos[None, :] <= q_pos[:, None], logits, NEG_INF)
        p = jax.nn.softmax(logits, axis=-1).astype(v.dtype)
        return jnp.einsum('bhqk,bkhe->bqhe', p, v)

    return sweep_query_blocks(block, q, cum).reshape(b, s, -1)


def mixing_sublayer(h, layer_idx, t5_table, cos, sin, w_in, b_forget, diff_lambda, diff_norm_g,
                    chunk_rel_bias, mla_q_norm_g, mla_kv_norm_g, mla_w_uq, mla_w_ukv,
                    w_gate, b_gate, w_branch, w_out):
    b, s, _ = h.shape
    (dq, dk, dv, cq, ck, cv, mq, mkv, mkr, fq, fk, fv, ff) = jnp.split(h @ w_in, IN_OFFSETS, axis=-1)
    o_diff = differential_attention(dq.reshape(b, s, DIFF_HEADS, 2, DIFF_DH), dk.reshape(b, s, DIFF_HEADS, 2, DIFF_DH),
                                    dv.reshape(b, s, DIFF_HEADS, 2 * DIFF_DH), diff_lambda, diff_norm_g,
                                    t5_table, layer_idx)
    o_chunk = chunk_band_attention(cq.reshape(b, s, CHUNK_HEADS, HEAD_DIM), ck.reshape(b, s, CHUNK_HEADS, HEAD_DIM),
                                   cv.reshape(b, s, CHUNK_HEADS, HEAD_DIM), chunk_rel_bias)
    o_mla = latent_attention(mq, mkv, mkr, mla_q_norm_g, mla_kv_norm_g, mla_w_uq, mla_w_ukv, cos, sin)
    o_fox = forgetting_attention(fq.reshape(b, s, FOX_HEADS, HEAD_DIM), fk.reshape(b, s, FOX_HEADS, HEAD_DIM),
                                 fv.reshape(b, s, FOX_HEADS, HEAD_DIM), ff + b_forget)
    merged = jnp.zeros_like(h)
    for n, o_n in enumerate((o_diff, o_chunk, o_mla, o_fox)):
        gate = jax.nn.sigmoid(h @ w_gate[n] + b_gate[n])
        merged = merged + gate * (o_n @ w_branch[n])
    return merged @ w_out


def hierarchical_moe(x, wg, bg, we, be, w1, w3, w2):
    b, s, d = x.shape
    n_tok = b * s
    xt = x.reshape(n_tok, d)
    g_prob = jax.nn.softmax((xt @ wg).astype(jnp.float32) + bg.astype(jnp.float32), axis=-1)
    g_val, g_idx = lax.top_k(g_prob, 1)
    e_logits = ((xt @ we).astype(jnp.float32) + be.astype(jnp.float32)).reshape(n_tok, N_GROUPS, EXPERTS_PER_GROUP)
    e_prob = jax.nn.softmax(e_logits[jnp.arange(n_tok), g_idx[:, 0]], axis=-1)
    e_val, e_loc = lax.top_k(e_prob, TOP_K)
    gate = g_val * e_val / jnp.sum(e_val, axis=-1, keepdims=True)
    expert = (g_idx * EXPERTS_PER_GROUP + e_loc).reshape(-1)
    n_slots = n_tok * TOP_K
    token = jnp.arange(n_slots) // TOP_K
    onehot = jax.nn.one_hot(expert, N_EXPERTS, dtype=jnp.int32)
    rank = jnp.cumsum(onehot, axis=0)[jnp.arange(n_slots), expert] - 1
    counts = jnp.sum(onehot, axis=0)
    padded = (counts + MOE_BLOCK - 1) // MOE_BLOCK * MOE_BLOCK
    pad_end = jnp.cumsum(padded)
    dest = (pad_end - padded)[expert] + rank
    n_blocks = -(-n_slots // MOE_BLOCK) + N_EXPERTS
    tok_buf = jnp.zeros((n_blocks * MOE_BLOCK,), jnp.int32).at[dest].set(token)
    gate_buf = jnp.zeros((n_blocks * MOE_BLOCK,), jnp.float32).at[dest].set(gate.reshape(-1))
    blk_start = jnp.arange(n_blocks) * MOE_BLOCK
    blk_expert = jnp.minimum(jnp.sum(pad_end[None, :] <= blk_start[:, None], axis=1), N_EXPERTS - 1)

    def run_block(args):
        e, idx, g = args
        xb = xt[idx]
        hb = jax.nn.silu(xb @ w1[e]) * (xb @ w3[e])
        return (hb @ w2[e]) * g[:, None].astype(x.dtype)

    y_buf = lax.map(run_block, (blk_expert, tok_buf.reshape(n_blocks, MOE_BLOCK), gate_buf.reshape(n_blocks, MOE_BLOCK)))
    y = jnp.zeros_like(xt).at[tok_buf].add(y_buf.reshape(-1, d))
    return y.reshape(b, s, d)


def setup_inputs(seed: int = 0) -> dict:
    key = jax.random.key(seed)
    ks = jax.random.split(key, 32)
    L = DEPTH

    def nrm(k, shape, scale):
        return jax.random.normal(k, shape, jnp.float32) * scale

    return {
        'x': nrm(ks[0], (BATCH, SEQ, D_MODEL), 1.0),
        'ln_in_g': 1.0 + nrm(ks[1], (D_MODEL,), 0.02),
        'ln_in_b': nrm(ks[2], (D_MODEL,), 0.02),
        't5_table': nrm(ks[3], (T5_BUCKETS, DIFF_HEADS), 0.5),
        'w_in': nrm(ks[4], (L, D_MODEL, D_IN), D_MODEL ** -0.5),
        'b_forget': 3.0 + nrm(ks[5], (L, FOX_HEADS), 0.1),
        'diff_lambda': nrm(ks[6], (L, 4, DIFF_DH), 0.1),
        'diff_norm_g': 1.0 + nrm(ks[7], (L, 2 * DIFF_DH), 0.02),
        'chunk_rel_bias': nrm(ks[8], (L, 2 * REL_CLIP + 1, CHUNK_HEADS), 0.5),
        'mla_q_norm_g': 1.0 + nrm(ks[9], (L, MLA_Q_LORA), 0.02),
        'mla_kv_norm_g': 1.0 + nrm(ks[10], (L, MLA_KV_LORA), 0.02),
        'mla_w_uq': nrm(ks[11], (L, MLA_Q_LORA, MLA_HEADS * (MLA_NOPE + MLA_ROPE)), MLA_Q_LORA ** -0.5),
        'mla_w_ukv': nrm(ks[12], (L, MLA_KV_LORA, MLA_HEADS * (MLA_NOPE + MLA_V)), MLA_KV_LORA ** -0.5),
        'w_gate': nrm(ks[13], (L, N_BRANCHES, D_MODEL, D_MODEL), D_MODEL ** -0.5),
        'b_gate': nrm(ks[14], (L, N_BRANCHES, D_MODEL), 0.02),
        'w_branch': nrm(ks[15], (L, N_BRANCHES, BRANCH_WIDTH, D_MODEL), BRANCH_WIDTH ** -0.5 * DEEPNORM_BETA),
        'w_out': nrm(ks[16], (L, D_MODEL, D_MODEL), D_MODEL ** -0.5 * DEEPNORM_BETA),
        'ln1_g': 1.0 + nrm(ks[17], (L, D_MODEL), 0.02),
        'ln1_b': nrm(ks[18], (L, D_MODEL), 0.02),
        'router_group_w': nrm(ks[19], (L, D_MODEL, N_GROUPS), D_MODEL ** -0.5),
        'router_group_b': nrm(ks[20], (L, N_GROUPS), 0.01),
        'router_expert_w': nrm(ks[21], (L, D_MODEL, N_EXPERTS), D_MODEL ** -0.5),
        'router_expert_b': nrm(ks[22], (L, N_EXPERTS), 0.01),
        'expert_w1': nrm(ks[23], (L, N_EXPERTS, D_MODEL, D_EXPERT), D_MODEL ** -0.5),
        'expert_w3': nrm(ks[24], (L, N_EXPERTS, D_MODEL, D_EXPERT), D_MODEL ** -0.5),
        'expert_w2': nrm(ks[25], (L, N_EXPERTS, D_EXPERT, D_MODEL), D_EXPERT ** -0.5 * DEEPNORM_BETA),
        'ln2_g': 1.0 + nrm(ks[26], (L, D_MODEL), 0.02),
        'ln2_b': nrm(ks[27], (L, D_MODEL), 0.02),
    }


def reference(x, ln_in_g, ln_in_b, t5_table, w_in, b_forget, diff_lambda, diff_norm_g, chunk_rel_bias,
              mla_q_norm_g, mla_kv_norm_g, mla_w_uq, mla_w_ukv, w_gate, b_gate, w_branch, w_out,
              ln1_g, ln1_b, router_group_w, router_group_b, router_expert_w, router_expert_b,
              expert_w1, expert_w3, expert_w2, ln2_g, ln2_b):
    s = x.shape[1]
    inv_freq = jnp.power(ROPE_BASE, -jnp.arange(MLA_ROPE // 2, dtype=jnp.float32) * 2.0 / MLA_ROPE)
    ang = jnp.arange(s, dtype=jnp.float32)[:, None] * inv_freq[None, :]
    cos, sin = jnp.cos(ang), jnp.sin(ang)
    h = layer_norm(x, ln_in_g, ln_in_b)
    for l in range(DEPTH):
        mix = mixing_sublayer(h, l, t5_table, cos, sin, w_in[l], b_forget[l], diff_lambda[l], diff_norm_g[l],
                              chunk_rel_bias[l], mla_q_norm_g[l], mla_kv_norm_g[l], mla_w_uq[l], mla_w_ukv[l],
                              w_gate[l], b_gate[l], w_branch[l], w_out[l])
        h = layer_norm(DEEPNORM_ALPHA * h + mix, ln1_g[l], ln1_b[l])
        ffn = hierarchical_moe(h, router_group_w[l], router_group_b[l], router_expert_w[l], router_expert_b[l],
                               expert_w1[l], expert_w3[l], expert_w2[l])
        h = layer_norm(DEEPNORM_ALPHA * h + ffn, ln2_g[l], ln2_b[l])
    return h
```

```cpp
#include <hip/hip_runtime.h>
#include <cstdio>
#include <cstdint>

#define GAS __attribute__((address_space(1)))
#define LAS __attribute__((address_space(3)))
typedef unsigned short bf16;
typedef short bf16x8 __attribute__((ext_vector_type(8)));
typedef float f32x4 __attribute__((ext_vector_type(4)));
typedef float f32x16 __attribute__((ext_vector_type(16)));
typedef unsigned u32x4 __attribute__((ext_vector_type(4)));
typedef unsigned u32x2 __attribute__((ext_vector_type(2)));

constexpr int NB = 4, SEQ = 8192, DM = 1024, NT = NB * SEQ, NL = 2;
constexpr int DIN = 2724, NPROJ = 2816;
constexpr int PC_DQ = 0, PC_DK = 256, PC_DV = 512, PC_BQ = 768, PC_BK = 1024, PC_BV = 1280, PC_CQ = 1536, PC_FQ = 1792, PC_FK = 2048, PC_FV = 2304,
              PC_CKV = 2560, PC_KR = 2688, PC_FF = 2720;
constexpr float LOG2E = 1.4426950408889634f;
constexpr float SC32 = 0.17677669529663687f * LOG2E, SC64 = 0.125f * LOG2E, SC96 = 0.10206207261596575f * LOG2E;
constexpr float LN_EPS = 1e-5f;
constexpr float DN_ALPHA = 1.4142135623730951f;
constexpr int NEXP = 32, DEXP = 512, NSLOT = NT * 2, MAXROWS = NSLOT + NEXP * 256;

constexpr size_t MiB = 1u << 20;
constexpr size_t WS_CTL = 0, CTL_BYTES = 1 * MiB;
constexpr size_t WS_WSM = 1 * MiB, WSM_STRIDE = 20 * MiB;
constexpr size_t WO_WIN = 0, WO_WG = 6 * MiB, WO_WB = 14 * MiB, WO_WO = 16 * MiB, WO_WUQ = 18 * MiB, WO_WUKV = 18 * MiB + 512 * 1024;
constexpr size_t WS_MISC = 41 * MiB;
constexpr size_t MO_ROPE = 0, MO_T5 = 1 * MiB, MO_RSTD = 1 * MiB + 64 * 1024, MO_CUM = 2 * MiB, MO_EID = 3 * MiB, MO_GATE = 3 * MiB + 512 * 1024, MO_INV = 4 * MiB, MO_LIST = 5 * MiB;
constexpr size_t WS_WEXP = 56 * MiB;
constexpr size_t WS_HB = 152 * MiB;
constexpr size_t WS_R1 = 216 * MiB;
constexpr size_t WS_R2 = 392 * MiB;
constexpr size_t WS_R3 = 456 * MiB;
constexpr size_t WS_END = 528 * MiB;
constexpr int CW_CNT = 1024;

constexpr int NWAVES = 8, NTHR = 512;
constexpr int LDS_BYTES = 147456;

struct Args { const float* in[28]; float* out; unsigned char* ws; int ph_lo, ph_hi; };

__device__ __forceinline__ unsigned f2bf(float f) { unsigned u = __builtin_bit_cast(unsigned, f); return (u + 0x7fffu + ((u >> 16) & 1u)) >> 16; }
__device__ __forceinline__ unsigned pk2(float lo, float hi) { return f2bf(lo) | (f2bf(hi) << 16); }
__device__ __forceinline__ float bflo(unsigned w) { return __builtin_bit_cast(float, w << 16); }
__device__ __forceinline__ float bfhi(unsigned w) { return __builtin_bit_cast(float, w & 0xffff0000u); }
__device__ __forceinline__ float bf2f(bf16 b) { return __builtin_bit_cast(float, (unsigned)b << 16); }
__device__ __forceinline__ int crow(int r, int hi) { return (r & 3) + 8 * (r >> 2) + 4 * hi; }
__device__ __forceinline__ float wave_sum(float v) {
#pragma unroll
    for (int o = 1; o < 64; o <<= 1) v += __shfl_xor(v, o);
    return v;
}
#define MFMA32(a, b, c) __builtin_amdgcn_mfma_f32_32x32x16_bf16(a, b, c, 0, 0, 0)

template <int N> __device__ __forceinline__ void wave_gemm(const bf16* arow, const bf16* const (&brow)[N], int K, int hi, f32x16 (&acc)[N]) {
#pragma unroll 4
    for (int k = 0; k < K; k += 16) {
        const bf16x8 a = *(const bf16x8*)(arow + k + 8 * hi);
#pragma unroll
        for (int n = 0; n < N; ++n) { const bf16x8 b = *(const bf16x8*)(brow[n] + k + 8 * hi); acc[n] = MFMA32(a, b, acc[n]); }
    }
}

template <class F> __device__ __forceinline__ void transpose_item(const F& f, bf16* WT, int ldk, int n0, int k0, LAS float* scr, int lane) {
#pragma unroll 8
    for (int i = 0; i < 32; ++i) { const int kk = 2 * i + (lane >> 5); scr[kk * 33 + (lane & 31)] = f(k0 + kk, n0 + (lane & 31)); }
    asm volatile("s_waitcnt lgkmcnt(0)" ::: "memory");
    const int c = lane & 7;
#pragma unroll
    for (int j = 0; j < 4; ++j) { const int n = (lane >> 3) + 8 * j; const LAS float* s = scr + (8 * c) * 33 + n;
        u32x4 o; o.x = pk2(s[0 * 33], s[1 * 33]); o.y = pk2(s[2 * 33], s[3 * 33]); o.z = pk2(s[4 * 33], s[5 * 33]); o.w = pk2(s[6 * 33], s[7 * 33]);
        *(u32x4*)(WT + (size_t)(n0 + n) * ldk + k0 + 8 * c) = o; }
    asm volatile("s_waitcnt lgkmcnt(0)" ::: "memory");
}
template <class F> __device__ __forceinline__ void conv_matrix(const F& f, bf16* WT, int nrows, int kcols, LAS float* scr, int lane, int gw, int ngw) {
    const int nkb = kcols / 64, items = (nrows / 32) * nkb;
    for (int it = gw; it < items; it += ngw) transpose_item(f, WT, kcols, (it / nkb) * 32, (it % nkb) * 64, scr, lane);
}

__device__ __forceinline__ void sincos_acc(float ang, float& s, float& c) {
    const double x = (double)ang; const double kq = __builtin_rint(x * 0.63661977236758134308);
    double r = __builtin_fma(-kq, 1.57079632679489655800e+00, x); r = __builtin_fma(-kq, 6.12323399573676603587e-17, r);
    const double r2 = r * r;
    double sp = r * (1.0 + r2 * (-1.0 / 6 + r2 * (1.0 / 120 + r2 * (-1.0 / 5040 + r2 * (1.0 / 362880 + r2 * (-1.0 / 39916800 + r2 * (1.0 / 6227020800.0)))))));
    double cp = 1.0 + r2 * (-0.5 + r2 * (1.0 / 24 + r2 * (-1.0 / 720 + r2 * (1.0 / 40320 + r2 * (-1.0 / 3628800 + r2 * (1.0 / 479001600.0))))));
    const int q = ((int)kq) & 3;
    double ss = (q & 1) ? cp : sp, cc = (q & 1) ? sp : cp;
    if (q == 1) cc = -cc; else if (q == 2) { ss = -ss; cc = -cc; } else if (q == 3) ss = -ss;
    s = (float)ss; c = (float)cc;
}

struct Ctx {
    const float* in[28]; float* hf; unsigned char* ws; LAS unsigned char* lds;
    int tid, lane, wave, gw, ngw, G;
};
#define WSP(type, off) ((type*)(C.ws + (off)))

__device__ __forceinline__ void ln_row(f32x4 (&v)[4], const float* g, const float* b, float* hfrow, bf16* hbrow, int lane) {
    float s = 0.f;
#pragma unroll
    for (int j = 0; j < 4; ++j) s += (v[j].x + v[j].y) + (v[j].z + v[j].w);
    const float mean = wave_sum(s) * (1.f / DM); float s2 = 0.f;
#pragma unroll
    for (int j = 0; j < 4; ++j) { v[j] = v[j] - mean; s2 += (v[j].x * v[j].x + v[j].y * v[j].y) + (v[j].z * v[j].z + v[j].w * v[j].w); }
    const float rstd = 1.f / sqrtf(wave_sum(s2) * (1.f / DM) + LN_EPS);
#pragma unroll
    for (int j = 0; j < 4; ++j) { const f32x4 gg = *(const f32x4*)(g + 4 * lane + 256 * j), bb = *(const f32x4*)(b + 4 * lane + 256 * j);
        v[j] = v[j] * rstd * gg + bb;
        *(f32x4*)(hfrow + 4 * lane + 256 * j) = v[j];
        u32x2 o; o.x = pk2(v[j].x, v[j].y); o.y = pk2(v[j].z, v[j].w); *(u32x2*)(hbrow + 4 * lane + 256 * j) = o; }
}

__device__ __forceinline__ void ph_prologue(const Ctx& C) {
    LAS float* scr = (LAS float*)(C.lds + C.wave * 16384);
    for (int l = 0; l < NL; ++l) {
        unsigned char* wb = C.ws + WS_WSM + l * WSM_STRIDE;
        { const float* W = C.in[4] + (size_t)l * DM * DIN;
          auto f = [W](int k, int n) -> float { int src; float sc = 1.f;
              if (n < 1792) { src = n; if (n < 256) sc = SC32; else if (n >= 768 && n < 1024) sc = SC64; }
              else if (n < 2560) { src = 1952 + (n - 1792); if (n < 2048) sc = SC64; }
              else if (n < 2688) src = 1792 + (n - 2560);
              else if (n < 2720) { const int i = n - 2688; src = 1920 + (i & 1) * 16 + (i >> 1); }
              else if (n < 2724) src = n;
              else return 0.f;
              return W[(size_t)k * DIN + src] * sc; };
          conv_matrix(f, (bf16*)(wb + WO_WIN), NPROJ, DM, scr, C.lane, C.gw, C.ngw); }
        { const float* W = C.in[13] + (size_t)l * 4 * DM * DM;
          auto f = [W](int k, int n) -> float { return W[((size_t)(n >> 10) * DM + k) * DM + (n & 1023)]; };
          conv_matrix(f, (bf16*)(wb + WO_WG), 4 * DM, DM, scr, C.lane, C.gw, C.ngw); }
        { const float* W = C.in[15] + (size_t)l * 4 * 256 * DM;
          auto f = [W](int k, int n) -> float { return W[(size_t)k * DM + n]; };
          conv_matrix(f, (bf16*)(wb + WO_WB), DM, DM, scr, C.lane, C.gw, C.ngw); }
        { const float* W = C.in[16] + (size_t)l * DM * DM;
          auto f = [W](int k, int n) -> float { return W[(size_t)k * DM + n]; };
          conv_matrix(f, (bf16*)(wb + WO_WO), DM, DM, scr, C.lane, C.gw, C.ngw); }
        { const float* W = C.in[11] + (size_t)l * 256 * 384; const float* g = C.in[9] + l * 256;
          auto f = [W, g](int k, int n) -> float { if (n >= 384) return 0.f; const int h = n / 96, d = n % 96; int src = n;
              if (d >= 64) { const int i = d - 64; src = h * 96 + 64 + (i & 1) * 16 + (i >> 1); }
              return W[(size_t)k * 384 + src] * g[k] * SC96; };
          conv_matrix(f, (bf16*)(wb + WO_WUQ), 512, 256, scr, C.lane, C.gw, C.ngw); }
        { const float* W = C.in[12] + (size_t)l * 128 * 512; const float* g = C.in[10] + l * 128;
          auto f = [W, g](int k, int n) -> float { if (k >= 128) return 0.f; const int src = (n < 256) ? ((n >> 6) * 128 + (n & 63)) : (((n - 256) >> 6) * 128 + 64 + (n & 63));
              return W[(size_t)k * 512 + src] * g[k]; };
          conv_matrix(f, (bf16*)(wb + WO_WUKV), 512, 256, scr, C.lane, C.gw, C.ngw); }
    }
    { float* rope = WSP(float, WS_MISC + MO_ROPE); const int gt = C.gw * 64 + C.lane, ngt = C.ngw * 64;
      for (int i = gt; i < SEQ * 16; i += ngt) { const int pos = i >> 4, f = i & 15;
          const float invf = powf(10000.0f, -(float)f * 2.0f / 32.0f); const float ang = (float)pos * invf; float s, c; sincos_acc(ang, s, c);
          rope[2 * i] = c; rope[2 * i + 1] = s; }
      float* t5 = WSP(float, WS_MISC + MO_T5);
      for (int i = gt; i < 4 * 192; i += ngt) { const int h = i / 192, rel = (i % 192) - 128; const int n = rel < 0 ? -rel : rel; int bk;
          if (n < 8) bk = n; else if (n < 12) bk = 8; else if (n < 16) bk = 9; else if (n < 23) bk = 10; else if (n < 32) bk = 11; else if (n < 46) bk = 12; else if (n < 64) bk = 13; else if (n < 91) bk = 14; else bk = 15;
          if (rel > 0) bk += 16;
          t5[i] = C.in[3][bk * 4 + h] * LOG2E; } }
    bf16* hb = WSP(bf16, WS_HB);
    for (int m = C.gw; m < NT; m += C.ngw) { f32x4 v[4];
#pragma unroll
        for (int j = 0; j < 4; ++j) v[j] = *(const f32x4*)(C.in[0] + (size_t)m * DM + 4 * C.lane + 256 * j);
        ln_row(v, C.in[1], C.in[2], C.hf + (size_t)m * DM, hb + (size_t)m * DM, C.lane); }
}

__device__ __forceinline__ void ph_proj(const Ctx& C, int l) {
    const bf16* hb = WSP(bf16, WS_HB); const bf16* W = WSP(bf16, WS_WSM + l * WSM_STRIDE + WO_WIN); bf16* proj = WSP(bf16, WS_R1);
    const int r = C.lane & 31, hi = C.lane >> 5; constexpr int NCT = NPROJ / 64;
    for (int u = C.gw; u < (NT / 32) * NCT; u += C.ngw) { const int rt = u / NCT, ct = u % NCT;
        f32x16 acc[2] = {f32x16{}, f32x16{}}; const bf16* brow[2] = {W + (size_t)(ct * 64 + r) * DM, W + (size_t)(ct * 64 + 32 + r) * DM};
        wave_gemm<2>(hb + (size_t)(rt * 32 + r) * DM, brow, DM, hi, acc);
#pragma unroll
        for (int n = 0; n < 2; ++n)
#pragma unroll
            for (int g = 0; g < 16; ++g) proj[(size_t)(rt * 32 + crow(g, hi)) * NPROJ + ct * 64 + n * 32 + r] = (bf16)f2bf(acc[n][g]); }
}

__device__ __forceinline__ float log_sigmoid(float x) { return fminf(x, 0.f) - log1pf(expf(-fabsf(x))); }
__device__ __forceinline__ void ph_thin(const Ctx& C, int l) {
    const bf16* proj = WSP(bf16, WS_R1); float* rstd = WSP(float, WS_MISC + MO_RSTD); bf16* mk = WSP(bf16, WS_R2 + 24 * MiB); const float* rope = WSP(float, WS_MISC + MO_ROPE);
    for (int m = C.gw; m < NT; m += C.ngw) { const bf16* row = proj + (size_t)m * NPROJ;
        const u32x2 cq = *(const u32x2*)(row + PC_CQ + 4 * C.lane); const unsigned ckv = *(const unsigned*)(row + PC_CKV + 2 * C.lane);
        float sq = bflo(cq.x) * bflo(cq.x) + bfhi(cq.x) * bfhi(cq.x) + bflo(cq.y) * bflo(cq.y) + bfhi(cq.y) * bfhi(cq.y);
        float skv = bflo(ckv) * bflo(ckv) + bfhi(ckv) * bfhi(ckv);
        sq = wave_sum(sq); skv = wave_sum(skv);
        if (C.lane == 0) { rstd[2 * m] = 1.f / sqrtf(sq * (1.f / 256) + LN_EPS); rstd[2 * m + 1] = 1.f / sqrtf(skv * (1.f / 128) + LN_EPS); }
        if (C.lane < 16) { const unsigned kr = *(const unsigned*)(row + PC_KR + 2 * C.lane); const float x1 = bflo(kr), x2 = bfhi(kr);
            const int pos = m & (SEQ - 1); const float c = rope[(pos * 16 + C.lane) * 2], s = rope[(pos * 16 + C.lane) * 2 + 1];
            const unsigned o = pk2(x1 * c - x2 * s, x1 * s + x2 * c);
#pragma unroll
            for (int h = 0; h < 4; ++h) *(unsigned*)(mk + (size_t)m * 384 + h * 96 + 64 + 2 * C.lane) = o; } }
    if (blockIdx.x < NB) {
        const int b = blockIdx.x; LAS float* wt = (LAS float*)(C.lds + 131072); float* cum = WSP(float, WS_MISC + MO_CUM); const float* bf = C.in[5] + l * 4;
        float loc[4][16]; float tot[4] = {0.f, 0.f, 0.f, 0.f};
#pragma unroll
        for (int i = 0; i < 16; ++i) { const size_t m = (size_t)b * SEQ + C.tid * 16 + i; const u32x2 ff = *(const u32x2*)(proj + m * NPROJ + PC_FF);
            const float x[4] = {bflo(ff.x), bfhi(ff.x), bflo(ff.y), bfhi(ff.y)};
#pragma unroll
            for (int h = 0; h < 4; ++h) { tot[h] += log_sigmoid(x[h] + bf[h]) * LOG2E; loc[h][i] = tot[h]; } }
        float excl[4];
#pragma unroll
        for (int h = 0; h < 4; ++h) { float inc = tot[h];
#pragma unroll
            for (int o = 1; o < 64; o <<= 1) { const float y = __shfl_up(inc, o); if (C.lane >= o) inc += y; }
            if (C.lane == 63) wt[h * 8 + C.wave] = inc;
            excl[h] = inc - tot[h]; }
        __syncthreads();
#pragma unroll
        for (int h = 0; h < 4; ++h) { float p = 0.f; for (int w = 0; w < C.wave; ++w) p += wt[h * 8 + w]; excl[h] += p; }
#pragma unroll
        for (int i = 0; i < 16; ++i) { const size_t m = (size_t)b * SEQ + C.tid * 16 + i;
            *(f32x4*)(cum + m * 4) = (f32x4){excl[0] + loc[0][i], excl[1] + loc[1][i], excl[2] + loc[2][i], excl[3] + loc[3][i]}; }
        __syncthreads();
    }
}

__device__ __forceinline__ void ph_mla_up(const Ctx& C, int l) {
    const bf16* proj = WSP(bf16, WS_R1); const float* rstd = WSP(float, WS_MISC + MO_RSTD); const float* rope = WSP(float, WS_MISC + MO_ROPE);
    const bf16* Wq = WSP(bf16, WS_WSM + l * WSM_STRIDE + WO_WUQ); const bf16* Wkv = WSP(bf16, WS_WSM + l * WSM_STRIDE + WO_WUKV);
    bf16* mq = WSP(bf16, WS_R2); bf16* mk = WSP(bf16, WS_R2 + 24 * MiB); bf16* mv = WSP(bf16, WS_R2 + 48 * MiB);
    const int r = C.lane & 31, hi = C.lane >> 5;
    for (int u = C.gw; u < (NT / 32) * 14; u += C.ngw) { const int rt = u / 14, ct = u % 14;
        f32x16 acc[2] = {f32x16{}, f32x16{}};
        if (ct < 6) {
            const bf16* brow[2] = {Wq + (size_t)(ct * 64 + r) * 256, Wq + (size_t)(ct * 64 + 32 + r) * 256};
            wave_gemm<2>(proj + (size_t)(rt * 32 + r) * NPROJ + PC_CQ, brow, 256, hi, acc);
#pragma unroll
            for (int n = 0; n < 2; ++n) { const int col = ct * 64 + n * 32 + r, d = col % 96;
#pragma unroll
                for (int g = 0; g < 16; ++g) { const int m = rt * 32 + crow(g, hi); float v = acc[n][g] * rstd[2 * m];
                    const float other = __shfl_xor(v, 1);
                    if (d >= 64) { const int i = (d - 64) >> 1, pos = m & (SEQ - 1); const float c = rope[(pos * 16 + i) * 2], s = rope[(pos * 16 + i) * 2 + 1];
                        v = (d & 1) ? (other * s + v * c) : (v * c - other * s); }
                    mq[(size_t)m * 384 + col] = (bf16)f2bf(v); } }
        } else { const int c2 = ct - 6;
            const bf16* brow[2] = {Wkv + (size_t)(c2 * 64 + r) * 256, Wkv + (size_t)(c2 * 64 + 32 + r) * 256};
            wave_gemm<2>(proj + (size_t)(rt * 32 + r) * NPROJ + PC_CKV, brow, 256, hi, acc);
#pragma unroll
            for (int n = 0; n < 2; ++n) { const int col = c2 * 64 + n * 32 + r;
#pragma unroll
                for (int g = 0; g < 16; ++g) { const int m = rt * 32 + crow(g, hi); const float v = acc[n][g] * rstd[2 * m + 1];
                    if (col < 256) mk[(size_t)m * 384 + (col >> 6) * 96 + (col & 63)] = (bf16)f2bf(v); else mv[(size_t)m * 256 + (col - 256)] = (bf16)f2bf(v); } }
        } }
}

template <int DQK, int TYPE> __device__ __forceinline__ void attn_pass(const bf16* qrow, const bf16* kbase, int kstride, const bf16* vbase, int vstride,
        int j0, int j1, int t, const float* btab, int h, float cq, const float* cumk, float (&o)[64]) {
    float q[DQK];
#pragma unroll
    for (int i = 0; i < DQK / 8; ++i) { const u32x4 w = *(const u32x4*)(qrow + 8 * i);
        q[8 * i] = bflo(w.x); q[8 * i + 1] = bfhi(w.x); q[8 * i + 2] = bflo(w.y); q[8 * i + 3] = bfhi(w.y); q[8 * i + 4] = bflo(w.z); q[8 * i + 5] = bfhi(w.z); q[8 * i + 6] = bflo(w.w); q[8 * i + 7] = bfhi(w.w); }
#pragma unroll
    for (int e = 0; e < 64; ++e) o[e] = 0.f;
    float m = -1e30f, lsum = 0.f;
    for (int j = j0; j < j1; ++j) {
        const bf16* kr = kbase + (size_t)j * kstride; float s0 = 0.f, s1 = 0.f;
#pragma unroll
        for (int i = 0; i < DQK / 8; ++i) { const u32x4 w = *(const u32x4*)(kr + 8 * i);
            s0 += q[8 * i] * bflo(w.x); s1 += q[8 * i + 1] * bfhi(w.x); s0 += q[8 * i + 2] * bflo(w.y); s1 += q[8 * i + 3] * bfhi(w.y);
            s0 += q[8 * i + 4] * bflo(w.z); s1 += q[8 * i + 5] * bfhi(w.z); s0 += q[8 * i + 6] * bflo(w.w); s1 += q[8 * i + 7] * bfhi(w.w); }
        float s = s0 + s1; bool ok = true;
        if (TYPE == 0) { int rel = j - t; rel = rel < -128 ? -128 : rel; s += btab[h * 192 + rel + 128]; }
        if (TYPE == 1) { int rel = j - t; rel = rel < -128 ? -128 : (rel > 128 ? 128 : rel); s += btab[(rel + 128) * 4 + h] * LOG2E; }
        if (TYPE == 3) { s += cq - cumk[(size_t)j * 4]; ok = (j <= t); }
        if (ok) {
            if (s > m) { const float f = exp2f(m - s); lsum *= f;
#pragma unroll
                for (int e = 0; e < 64; ++e) o[e] *= f;
                m = s; }
            const float p = exp2f(s - m); lsum += p;
            const bf16* vr = vbase + (size_t)j * vstride;
#pragma unroll
            for (int i = 0; i < 8; ++i) { const u32x4 w = *(const u32x4*)(vr + 8 * i);
                o[8 * i] += p * bflo(w.x); o[8 * i + 1] += p * bfhi(w.x); o[8 * i + 2] += p * bflo(w.y); o[8 * i + 3] += p * bfhi(w.y);
                o[8 * i + 4] += p * bflo(w.z); o[8 * i + 5] += p * bfhi(w.z); o[8 * i + 6] += p * bflo(w.w); o[8 * i + 7] += p * bfhi(w.w); }
        }
    }
    const float inv = 1.f / lsum;
#pragma unroll
    for (int e = 0; e < 64; ++e) o[e] *= inv;
}
__device__ __forceinline__ void store_o64(bf16* dst, const float (&o)[64]) {
#pragma unroll
    for (int i = 0; i < 8; ++i) { u32x4 w; w.x = pk2(o[8 * i], o[8 * i + 1]); w.y = pk2(o[8 * i + 2], o[8 * i + 3]); w.z = pk2(o[8 * i + 4], o[8 * i + 5]); w.w = pk2(o[8 * i + 6], o[8 * i + 7]); *(u32x4*)(dst + 8 * i) = w; }
}
__device__ __forceinline__ void ph_attn(const Ctx& C, int l) {
    const bf16* proj = WSP(bf16, WS_R1); const bf16* mq = WSP(bf16, WS_R2); const bf16* mk = WSP(bf16, WS_R2 + 24 * MiB); const bf16* mv = WSP(bf16, WS_R2 + 48 * MiB);
    const float* cum = WSP(float, WS_MISC + MO_CUM); const float* t5 = WSP(float, WS_MISC + MO_T5); bf16* O = WSP(bf16, WS_R3);
    float lam_full; const float lam_init = 0.8f - 0.6f * expf(-0.3f * (float)l);
    { const float* lm = C.in[6] + l * 128; float a = 0.f, b = 0.f; for (int i = 0; i < 32; ++i) { a += lm[i] * lm[32 + i]; b += lm[64 + i] * lm[96 + i]; } lam_full = expf(a) - expf(b) + lam_init; }
    const float* dng = C.in[7] + l * 64; const float* relb = C.in[8] + (size_t)l * 257 * 4;
    constexpr int NU = NB * 4 * (SEQ / 64);
    for (int uu = C.gw; uu < 4 * NU; uu += C.ngw) {
        const int type = uu / NU; int u = uu % NU; if (type & 1) u = NU - 1 - u;
        const int qc = u % (SEQ / 64), bh = u / (SEQ / 64), b = bh >> 2, h = bh & 3;
        const int t = qc * 64 + C.lane; const size_t rb = (size_t)b * SEQ, m = rb + t;
        float o[64];
        if (type == 0) {
            float o0[64];
            attn_pass<32, 0>(proj + m * NPROJ + PC_DQ + h * 64, proj + rb * NPROJ + PC_DK + h * 64, NPROJ, proj + rb * NPROJ + PC_DV + h * 64, NPROJ, 0, (qc + 1) * 64, t, t5, h, 0.f, nullptr, o0);
            attn_pass<32, 0>(proj + m * NPROJ + PC_DQ + h * 64 + 32, proj + rb * NPROJ + PC_DK + h * 64 + 32, NPROJ, proj + rb * NPROJ + PC_DV + h * 64, NPROJ, 0, (qc + 1) * 64, t, t5, h, 0.f, nullptr, o);
            float ss = 0.f;
#pragma unroll
            for (int e = 0; e < 64; ++e) { o[e] = o0[e] - lam_full * o[e]; ss += o[e] * o[e]; }
            const float rs = (1.f / sqrtf(ss * (1.f / 64) + LN_EPS)) * (1.f - lam_init);
#pragma unroll
            for (int e = 0; e < 64; ++e) o[e] = o[e] * rs * dng[e];
        } else if (type == 1) {
            const int j0 = qc >= 8 ? (qc - 8) * 64 : 0;
            attn_pass<64, 1>(proj + m * NPROJ + PC_BQ + h * 64, proj + rb * NPROJ + PC_BK + h * 64, NPROJ, proj + rb * NPROJ + PC_BV + h * 64, NPROJ, j0, (qc + 1) * 64, t, relb, h, 0.f, nullptr, o);
        } else if (type == 2) {
            attn_pass<96, 2>(mq + m * 384 + h * 96, mk + rb * 384 + h * 96, 384, mv + rb * 256 + h * 64, 256, 0, (qc + 1) * 64, t, nullptr, h, 0.f, nullptr, o);
        } else {
            attn_pass<64, 3>(proj + m * NPROJ + PC_FQ + h * 64, proj + rb * NPROJ + PC_FK + h * 64, NPROJ, proj + rb * NPROJ + PC_FV + h * 64, NPROJ, 0, (qc + 1) * 64, t, nullptr, h, cum[m * 4 + h], cum + rb * 4 + h, o);
        }
        store_o64(O + m * DM + type * 256 + h * 64, o);
    }
}

__device__ __forceinline__ void ph_merge(const Ctx& C, int l) {
    const bf16* hb = WSP(bf16, WS_HB); const bf16* O = WSP(bf16, WS_R3); bf16* mg = WSP(bf16, WS_R2);
    const bf16* Wg = WSP(bf16, WS_WSM + l * WSM_STRIDE + WO_WG); const bf16* Wb = WSP(bf16, WS_WSM + l * WSM_STRIDE + WO_WB); const float* bg = C.in[14] + (size_t)l * 4 * DM;
    const int r = C.lane & 31, hi = C.lane >> 5;
    for (int u = C.gw; u < (NT / 32) * 16; u += C.ngw) { const int rt = u / 16, ct = u % 16;
        f32x16 tot[2] = {f32x16{}, f32x16{}};
        for (int n = 0; n < 4; ++n) {
            f32x16 ag[2] = {f32x16{}, f32x16{}}, ab[2] = {f32x16{}, f32x16{}};
            const bf16* browg[2] = {Wg + (size_t)(n * DM + ct * 64 + r) * DM, Wg + (size_t)(n * DM + ct * 64 + 32 + r) * DM};
            wave_gemm<2>(hb + (size_t)(rt * 32 + r) * DM, browg, DM, hi, ag);
            const bf16* browb[2] = {Wb + (size_t)(ct * 64 + r) * DM + n * 256, Wb + (size_t)(ct * 64 + 32 + r) * DM + n * 256};
            wave_gemm<2>(O + (size_t)(rt * 32 + r) * DM + n * 256, browb, 256, hi, ab);
#pragma unroll
            for (int c = 0; c < 2; ++c) { const float bias = bg[n * DM + ct * 64 + c * 32 + r];
#pragma unroll
                for (int g = 0; g < 16; ++g) { const float gate = 1.f / (1.f + expf(-(ag[c][g] + bias))); tot[c][g] += gate * ab[c][g]; } }
        }
#pragma unroll
        for (int c = 0; c < 2; ++c)
#pragma unroll
            for (int g = 0; g < 16; ++g) mg[(size_t)(rt * 32 + crow(g, hi)) * DM + ct * 64 + c * 32 + r] = (bf16)f2bf(tot[c][g]); }
}

__device__ __forceinline__ void ph_out(const Ctx& C, int l) {
    const bf16* mg = WSP(bf16, WS_R2); const bf16* W = WSP(bf16, WS_WSM + l * WSM_STRIDE + WO_WO); float* y1 = WSP(float, WS_R1);
    const int r = C.lane & 31, hi = C.lane >> 5;
    for (int u = C.gw; u < (NT / 32) * 16; u += C.ngw) { const int rt = u / 16, ct = u % 16;
        f32x16 acc[2] = {f32x16{}, f32x16{}}; const bf16* brow[2] = {W + (size_t)(ct * 64 + r) * DM, W + (size_t)(ct * 64 + 32 + r) * DM};
        wave_gemm<2>(mg + (size_t)(rt * 32 + r) * DM, brow, DM, hi, acc);
#pragma unroll
        for (int n = 0; n < 2; ++n)
#pragma unroll
            for (int g = 0; g < 16; ++g) { const size_t idx = (size_t)(rt * 32 + crow(g, hi)) * DM + ct * 64 + n * 32 + r; y1[idx] = DN_ALPHA * C.hf[idx] + acc[n][g]; } }
}

__device__ __forceinline__ void ph_ln1_route(const Ctx& C, int l) {
    { LAS float* scr = (LAS float*)(C.lds + C.wave * 16384);
      for (int e = 0; e < NEXP; ++e) { bf16* wb = WSP(bf16, WS_WEXP) + (size_t)e * 3 * DM * DEXP;
          { const float* W = C.in[23] + ((size_t)l * NEXP + e) * DM * DEXP; auto f = [W](int k, int n) -> float { return W[(size_t)k * DEXP + n]; }; conv_matrix(f, wb, DEXP, DM, scr, C.lane, C.gw, C.ngw); }
          { const float* W = C.in[24] + ((size_t)l * NEXP + e) * DM * DEXP; auto f = [W](int k, int n) -> float { return W[(size_t)k * DEXP + n]; }; conv_matrix(f, wb + (size_t)DM * DEXP, DEXP, DM, scr, C.lane, C.gw, C.ngw); }
          { const float* W = C.in[25] + ((size_t)l * NEXP + e) * DEXP * DM; auto f = [W](int k, int n) -> float { return W[(size_t)k * DM + n]; }; conv_matrix(f, wb + (size_t)2 * DM * DEXP, DM, DEXP, scr, C.lane, C.gw, C.ngw); } } }
    const float* y1 = WSP(float, WS_R1); bf16* hb = WSP(bf16, WS_HB);
    const float* g = C.in[17] + l * DM; const float* bb = C.in[18] + l * DM;
    const float* wg = C.in[19] + (size_t)l * DM * 4; const float* bgr = C.in[20] + l * 4; const float* we = C.in[21] + (size_t)l * DM * 32; const float* be = C.in[22] + l * 32;
    int* eid = WSP(int, WS_MISC + MO_EID); float* gatev = WSP(float, WS_MISC + MO_GATE); int* list = WSP(int, WS_MISC + MO_LIST); unsigned* cnt = WSP(unsigned, WS_CTL) + CW_CNT + l * 32;
    for (int m = C.gw; m < NT; m += C.ngw) { f32x4 v[4];
#pragma unroll
        for (int j = 0; j < 4; ++j) v[j] = *(const f32x4*)(y1 + (size_t)m * DM + 4 * C.lane + 256 * j);
        ln_row(v, g, bb, C.hf + (size_t)m * DM, hb + (size_t)m * DM, C.lane);
        f32x4 gl = {0.f, 0.f, 0.f, 0.f};
#pragma unroll
        for (int j = 0; j < 4; ++j)
#pragma unroll
            for (int i = 0; i < 4; ++i) { const int k = 4 * C.lane + 256 * j + i; gl += v[j][i] * *(const f32x4*)(wg + (size_t)k * 4); }
        float gg[4];
#pragma unroll
        for (int i = 0; i < 4; ++i) gg[i] = wave_sum(gl[i]) + bgr[i];
        int gi = 0; float gm = gg[0];
#pragma unroll
        for (int i = 1; i < 4; ++i) if (gg[i] > gm) { gm = gg[i]; gi = i; }
        float gs = 0.f;
#pragma unroll
        for (int i = 0; i < 4; ++i) gs += expf(gg[i] - gm);
        const float g_val = 1.f / gs;
        f32x4 e0 = {0.f, 0.f, 0.f, 0.f}, e1 = {0.f, 0.f, 0.f, 0.f};
#pragma unroll
        for (int j = 0; j < 4; ++j)
#pragma unroll
            for (int i = 0; i < 4; ++i) { const int k = 4 * C.lane + 256 * j + i; const float* wr = we + (size_t)k * 32 + gi * 8; e0 += v[j][i] * *(const f32x4*)wr; e1 += v[j][i] * *(const f32x4*)(wr + 4); }
        float el[8];
#pragma unroll
        for (int i = 0; i < 4; ++i) { el[i] = wave_sum(e0[i]) + be[gi * 8 + i]; el[4 + i] = wave_sum(e1[i]) + be[gi * 8 + 4 + i]; }
        int i1 = 0; float m1 = el[0];
#pragma unroll
        for (int i = 1; i < 8; ++i) if (el[i] > m1) { m1 = el[i]; i1 = i; }
        int i2 = -1; float m2 = -1e30f;
#pragma unroll
        for (int i = 0; i < 8; ++i) if (i != i1 && el[i] > m2) { m2 = el[i]; i2 = i; }
        const float p2 = expf(m2 - m1); const float ga = g_val / (1.f + p2), gb = g_val * p2 / (1.f + p2);
        if (C.lane == 0) { const int ea = gi * 8 + i1, eb = gi * 8 + i2;
            eid[2 * m] = ea; eid[2 * m + 1] = eb; gatev[2 * m] = ga; gatev[2 * m + 1] = gb;
            const unsigned ra = atomicAdd(cnt + ea, 1u), rb2 = atomicAdd(cnt + eb, 1u);
            list[(size_t)ea * NSLOT + ra] = 2 * m; list[(size_t)eb * NSLOT + rb2] = 2 * m + 1; } }
}

__device__ __forceinline__ void moe_tables(const Ctx& C, int l, LAS int* tb, LAS int* base, LAS int* cn) {
    const unsigned* cnt = WSP(unsigned, WS_CTL) + CW_CNT + l * 32;
    __syncthreads();
    if (C.tid == 0) { int t = 0, bs = 0; for (int e = 0; e < NEXP; ++e) { const int c = (int)__hip_atomic_load(cnt + e, __ATOMIC_RELAXED, __HIP_MEMORY_SCOPE_AGENT); cn[e] = c; tb[e] = t; base[e] = bs; t += (c + 31) / 32; bs += (c + 255) / 256 * 256; } tb[NEXP] = t; base[NEXP] = bs; }
    __syncthreads();
}

__device__ __forceinline__ void ph_exp_up(const Ctx& C, int l) {
    LAS int* tb = (LAS int*)(C.lds + 131072); LAS int* base = tb + 64; LAS int* cn = tb + 128;
    moe_tables(C, l, tb, base, cn);
    const bf16* hb = WSP(bf16, WS_HB); const int* list = WSP(int, WS_MISC + MO_LIST); bf16* hbuf = WSP(bf16, WS_R3); const bf16* wexp = WSP(bf16, WS_WEXP);
    const int r = C.lane & 31, hi = C.lane >> 5; const int ntile = tb[NEXP];
    for (int u = C.gw; u < ntile * 16; u += C.ngw) { const int tg = u / 16, ct = u % 16; int e = 0; while (tb[e + 1] <= tg) ++e;
        const int i = tg - tb[e], c = cn[e]; const int rr = i * 32 + r; const int tok = rr < c ? (list[(size_t)e * NSLOT + rr] >> 1) : 0;
        const bf16* w1 = wexp + (size_t)e * 3 * DM * DEXP; const bf16* w3 = w1 + (size_t)DM * DEXP;
        f32x16 acc[2] = {f32x16{}, f32x16{}}; const bf16* brow[2] = {w1 + (size_t)(ct * 32 + r) * DM, w3 + (size_t)(ct * 32 + r) * DM};
        wave_gemm<2>(hb + (size_t)tok * DM, brow, DM, hi, acc);
#pragma unroll
        for (int g = 0; g < 16; ++g) { const int rl = i * 32 + crow(g, hi); if (rl < c) { const float a = acc[0][g]; const float v = a / (1.f + expf(-a)) * acc[1][g];
            hbuf[(size_t)(base[e] + rl) * DEXP + ct * 32 + r] = (bf16)f2bf(v); } } }
}
__device__ __forceinline__ void ph_exp_down(const Ctx& C, int l) {
    LAS int* tb = (LAS int*)(C.lds + 131072); LAS int* base = tb + 64; LAS int* cn = tb + 128;
    moe_tables(C, l, tb, base, cn);
    const int* list = WSP(int, WS_MISC + MO_LIST); const bf16* hbuf = WSP(bf16, WS_R3); const bf16* wexp = WSP(bf16, WS_WEXP); const float* gatev = WSP(float, WS_MISC + MO_GATE);
    int* inv = WSP(int, WS_MISC + MO_INV); bf16* ys = WSP(bf16, WS_R1);
    const int r = C.lane & 31, hi = C.lane >> 5; const int ntile = tb[NEXP];
    for (int u = C.gw; u < ntile * 16; u += C.ngw) { const int tg = u / 16, ct = u % 16; int e = 0; while (tb[e + 1] <= tg) ++e;
        const int i = tg - tb[e], c = cn[e]; const int rr = i * 32 + r; const int arow = base[e] + (rr < c ? rr : 0);
        const bf16* w2 = wexp + (size_t)e * 3 * DM * DEXP + (size_t)2 * DM * DEXP;
        f32x16 acc[2] = {f32x16{}, f32x16{}}; const bf16* brow[2] = {w2 + (size_t)(ct * 64 + r) * DEXP, w2 + (size_t)(ct * 64 + 32 + r) * DEXP};
        wave_gemm<2>(hbuf + (size_t)arow * DEXP, brow, DEXP, hi, acc);
#pragma unroll
        for (int g = 0; g < 16; ++g) { const int rl = i * 32 + crow(g, hi); if (rl < c) { const int slot = list[(size_t)e * NSLOT + rl]; const float gt = gatev[slot]; const size_t dest = (size_t)(base[e] + rl);
            ys[dest * DM + ct * 64 + r] = (bf16)f2bf(acc[0][g] * gt); ys[dest * DM + ct * 64 + 32 + r] = (bf16)f2bf(acc[1][g] * gt);
            if (ct == 0 && r == 0) inv[slot] = (int)dest; } } }
}
__device__ __forceinline__ void ph_combine(const Ctx& C, int l) {
    const int* inv = WSP(int, WS_MISC + MO_INV); const bf16* ys = WSP(bf16, WS_R1); bf16* hb = WSP(bf16, WS_HB);
    const float* g = C.in[26] + l * DM; const float* bb = C.in[27] + l * DM;
    for (int m = C.gw; m < NT; m += C.ngw) { const size_t d0 = (size_t)inv[2 * m], d1 = (size_t)inv[2 * m + 1]; f32x4 v[4];
#pragma unroll
        for (int j = 0; j < 4; ++j) { const f32x4 x = *(const f32x4*)(C.hf + (size_t)m * DM + 4 * C.lane + 256 * j);
            const u32x2 a = *(const u32x2*)(ys + d0 * DM + 4 * C.lane + 256 * j), b = *(const u32x2*)(ys + d1 * DM + 4 * C.lane + 256 * j);
            v[j] = x * DN_ALPHA + (f32x4){bflo(a.x), bfhi(a.x), bflo(a.y), bfhi(a.y)} + (f32x4){bflo(b.x), bfhi(b.x), bflo(b.y), bfhi(b.y)}; }
        ln_row(v, g, bb, C.hf + (size_t)m * DM, hb + (size_t)m * DM, C.lane); }
}

constexpr int NPH_LAYER = 10;
template <int P, int THREADS, int WPS> __global__ void __launch_bounds__(THREADS, WPS) fwd_p(Args args) {
    extern __shared__ __attribute__((aligned(16))) unsigned char lds_raw[];
    Ctx C;
#pragma unroll
    for (int i = 0; i < 28; ++i) C.in[i] = args.in[i];
    C.hf = args.out; C.ws = args.ws; C.lds = (LAS unsigned char*)lds_raw;
    C.tid = threadIdx.x; C.lane = C.tid & 63; C.wave = __builtin_amdgcn_readfirstlane(C.tid >> 6); C.G = gridDim.x;
    C.gw = blockIdx.x * (blockDim.x >> 6) + C.wave; C.ngw = C.G * (blockDim.x >> 6);
    const int l = args.ph_lo;
    if (P == 0) ph_prologue(C);
    if (P == 1) ph_proj(C, l);
    if (P == 2) ph_thin(C, l);
    if (P == 3) ph_mla_up(C, l);
    if (P == 4) ph_attn(C, l);
    if (P == 5) ph_merge(C, l);
    if (P == 6) ph_out(C, l);
    if (P == 7) ph_ln1_route(C, l);
    if (P == 8) ph_exp_up(C, l);
    if (P == 9) ph_exp_down(C, l);
    if (P == 10) ph_combine(C, l);
}

extern "C" void kernel_launch(void* const* d_in, const int* in_sizes, int n_in, void* d_out, int out_size, void* d_ws, size_t ws_size, hipStream_t stream) {
    static int grid = 0;
    if (grid == 0) {
        if (n_in != 28 || out_size != NT * DM || ws_size < WS_END) { fprintf(stderr, "kernel_launch: unexpected shapes (n_in %d out %d ws %zu)\n", n_in, out_size, ws_size); grid = -1; return; }
        int dev = 0, cus = 0;
        if (hipGetDevice(&dev) != hipSuccess || hipDeviceGetAttribute(&cus, hipDeviceAttributeMultiprocessorCount, dev) != hipSuccess) { grid = -1; return; }
        bool ok = true;
        ok &= hipFuncSetAttribute((const void*)fwd_p<0, 512, 2>, hipFuncAttributeMaxDynamicSharedMemorySize, LDS_BYTES) == hipSuccess;
        ok &= hipFuncSetAttribute((const void*)fwd_p<2, 512, 2>, hipFuncAttributeMaxDynamicSharedMemorySize, LDS_BYTES) == hipSuccess;
        ok &= hipFuncSetAttribute((const void*)fwd_p<7, 512, 2>, hipFuncAttributeMaxDynamicSharedMemorySize, LDS_BYTES) == hipSuccess;
        ok &= hipFuncSetAttribute((const void*)fwd_p<8, 512, 2>, hipFuncAttributeMaxDynamicSharedMemorySize, LDS_BYTES) == hipSuccess;
        ok &= hipFuncSetAttribute((const void*)fwd_p<9, 512, 2>, hipFuncAttributeMaxDynamicSharedMemorySize, LDS_BYTES) == hipSuccess;
        if (!ok) { grid = -1; return; }
        grid = cus;
    }
    if (grid < 0) return;
    (void)hipMemsetAsync((char*)d_ws + WS_CTL, 0, CTL_BYTES, stream);
    Args a{};
    for (int i = 0; i < 28; ++i) a.in[i] = (const float*)d_in[i];
    a.out = (float*)d_out; a.ws = (unsigned char*)d_ws; a.ph_lo = 0; a.ph_hi = 0;
    hipLaunchKernelGGL((fwd_p<0, 512, 2>), dim3(grid), dim3(512), LDS_BYTES, stream, a);
    for (int l = 0; l < NL; ++l) { a.ph_lo = l;
        hipLaunchKernelGGL((fwd_p<1, 512, 2>), dim3(grid), dim3(512), 0, stream, a);
        hipLaunchKernelGGL((fwd_p<2, 512, 2>), dim3(grid), dim3(512), LDS_BYTES, stream, a);
        hipLaunchKernelGGL((fwd_p<3, 512, 2>), dim3(grid), dim3(512), 0, stream, a);
        hipLaunchKernelGGL((fwd_p<4, 256, 1>), dim3(grid * 2), dim3(256), 0, stream, a);
        hipLaunchKernelGGL((fwd_p<5, 512, 2>), dim3(grid), dim3(512), 0, stream, a);
        hipLaunchKernelGGL((fwd_p<6, 512, 2>), dim3(grid), dim3(512), 0, stream, a);
        hipLaunchKernelGGL((fwd_p<7, 512, 2>), dim3(grid), dim3(512), LDS_BYTES, stream, a);
        hipLaunchKernelGGL((fwd_p<8, 512, 2>), dim3(grid), dim3(512), LDS_BYTES, stream, a);
        hipLaunchKernelGGL((fwd_p<9, 512, 2>), dim3(grid), dim3(512), LDS_BYTES, stream, a);
        hipLaunchKernelGGL((fwd_p<10, 512, 2>), dim3(grid), dim3(512), 0, stream, a);
    }
}
```

```cpp
#include <hip/hip_runtime.h>
#include <cstdio>
#include <cstdint>
#ifndef PROBE_DUP
#define PROBE_DUP -1
#endif

#define GAS __attribute__((address_space(1)))
#define LAS __attribute__((address_space(3)))
typedef unsigned short bf16;
typedef short bf16x8 __attribute__((ext_vector_type(8)));
typedef float f32x4 __attribute__((ext_vector_type(4)));
typedef float f32x16 __attribute__((ext_vector_type(16)));
typedef unsigned u32x4 __attribute__((ext_vector_type(4)));
typedef unsigned u32x2 __attribute__((ext_vector_type(2)));

constexpr int NB = 4, SEQ = 8192, DM = 1024, NT = NB * SEQ, NL = 2;
constexpr int DIN = 2724, NPROJ = 2816;
constexpr int PC_DQ = 0, PC_DK = 256, PC_DV = 512, PC_BQ = 768, PC_BK = 1024, PC_BV = 1280, PC_CQ = 1536, PC_FQ = 1792, PC_FK = 2048, PC_FV = 2304,
              PC_CKV = 2560, PC_KR = 2688, PC_FF = 2720;
constexpr float LOG2E = 1.4426950408889634f;
constexpr float SC32 = 0.17677669529663687f * LOG2E, SC64 = 0.125f * LOG2E, SC96 = 0.10206207261596575f * LOG2E;
constexpr float LN_EPS = 1e-5f;
constexpr float DN_ALPHA = 1.4142135623730951f;
constexpr int NEXP = 32, DEXP = 512, NSLOT = NT * 2, MAXROWS = NSLOT + NEXP * 256;

constexpr size_t MiB = 1u << 20;
constexpr size_t WS_CTL = 0, CTL_BYTES = 1 * MiB;
constexpr size_t WS_WSM = 1 * MiB, WSM_STRIDE = 20 * MiB;
constexpr size_t WO_WIN = 0, WO_WG = 6 * MiB, WO_WB = 14 * MiB, WO_WO = 16 * MiB, WO_WUQ = 18 * MiB, WO_WUKV = 18 * MiB + 512 * 1024;
constexpr size_t WS_MISC = 41 * MiB;
constexpr size_t MO_ROPE = 0, MO_T5 = 1 * MiB, MO_RSTD = 1 * MiB + 64 * 1024, MO_WRT = 1 * MiB + 384 * 1024  , MO_SUM64 = 1 * MiB + 768 * 1024  , MO_CUM = 2 * MiB, MO_EID = 3 * MiB, MO_GATE = 3 * MiB + 512 * 1024, MO_INV = 4 * MiB, MO_LIST = 5 * MiB;
constexpr size_t WS_WEXP = 56 * MiB;
constexpr size_t WS_HB = 152 * MiB;
constexpr size_t WS_R1 = 216 * MiB;
constexpr size_t WS_R2 = 392 * MiB;
constexpr size_t WS_R3 = 456 * MiB;
constexpr size_t WS_END = 528 * MiB;
constexpr int CW_CNT = 1024, CW_QKMAX = 2048  , CW_BAR = 4096;

constexpr int NWAVES = 8, NTHR = 512;
constexpr int LDS_BYTES = 147456, LDS_TAB = 131072, LDS_MISC = 131072 + 4096;

struct Args { const float* in[28]; float* out; unsigned char* ws; int ph_lo, ph_hi; };

__device__ __forceinline__ unsigned f2bf(float f) { unsigned u = __builtin_bit_cast(unsigned, f); return (u + 0x7fffu + ((u >> 16) & 1u)) >> 16; }
__device__ __forceinline__ unsigned pk2(float lo, float hi) { return f2bf(lo) | (f2bf(hi) << 16); }
__device__ __forceinline__ float bflo(unsigned w) { return __builtin_bit_cast(float, w << 16); }
__device__ __forceinline__ float bfhi(unsigned w) { return __builtin_bit_cast(float, w & 0xffff0000u); }
__device__ __forceinline__ float bf2f(bf16 b) { return __builtin_bit_cast(float, (unsigned)b << 16); }
__device__ __forceinline__ int crow(int r, int hi) { return (r & 3) + 8 * (r >> 2) + 4 * hi; }
__device__ __forceinline__ int lane_id_asm() { int l; asm volatile("v_mbcnt_lo_u32_b32 %0, -1, 0\n\tv_mbcnt_hi_u32_b32 %0, -1, %0" : "=v"(l)); return l; }
__device__ __forceinline__ float shfl_xor_l(float v, int o, int lane) { return __builtin_bit_cast(float, __builtin_amdgcn_ds_bpermute((lane ^ o) << 2, __builtin_bit_cast(int, v))); }
__device__ __forceinline__ float shfl_up_l(float v, int o, int lane) { return __builtin_bit_cast(float, __builtin_amdgcn_ds_bpermute((lane - o) << 2, __builtin_bit_cast(int, v))); }
__device__ __forceinline__ float wave_sum_l(float v, int) {
    v += __builtin_bit_cast(float, __builtin_amdgcn_update_dpp(0, __builtin_bit_cast(int, v), 0x111, 0xf, 0xf, true));
    v += __builtin_bit_cast(float, __builtin_amdgcn_update_dpp(0, __builtin_bit_cast(int, v), 0x112, 0xf, 0xf, true));
    v += __builtin_bit_cast(float, __builtin_amdgcn_update_dpp(0, __builtin_bit_cast(int, v), 0x114, 0xf, 0xf, true));
    v += __builtin_bit_cast(float, __builtin_amdgcn_update_dpp(0, __builtin_bit_cast(int, v), 0x118, 0xf, 0xf, true));
    v += __builtin_bit_cast(float, __builtin_amdgcn_update_dpp(0, __builtin_bit_cast(int, v), 0x142, 0xa, 0xf, false));
    v += __builtin_bit_cast(float, __builtin_amdgcn_update_dpp(0, __builtin_bit_cast(int, v), 0x143, 0xc, 0xf, false));
    return __builtin_bit_cast(float, __builtin_amdgcn_readlane(__builtin_bit_cast(int, v), 63));
}
__device__ __forceinline__ unsigned cvtpk(float lo, float hi) { unsigned r; asm("v_cvt_pk_bf16_f32 %0, %1, %2" : "=v"(r) : "v"(lo), "v"(hi)); return r; }
__device__ __forceinline__ unsigned cvtpk_dep(float lo, float hi, float dep) { unsigned r; asm("v_cvt_pk_bf16_f32 %0, %1, %2" : "=v"(r) : "v"(lo), "v"(hi), "v"(dep)); return r; }
__device__ __forceinline__ void glds16(const void* gbase, unsigned voff, unsigned lds_dst) { unsigned keep;
    asm volatile("s_mov_b32 %0, m0\n\ts_mov_b32 m0, %3\n\ts_nop 0\n\tglobal_load_lds_dwordx4 %1, %2\n\ts_mov_b32 m0, %0" : "=&s"(keep) : "v"(voff), "s"(gbase), "s"(lds_dst) : "memory"); }
#define MFMA32(a, b, c) __builtin_amdgcn_mfma_f32_32x32x16_bf16(a, b, c, 0, 0, 0)

template <int N> __device__ __forceinline__ void wave_gemm(const bf16* arow, const bf16* const (&brow)[N], int K, int hi, f32x16 (&acc)[N]) {
#pragma unroll 4
    for (int k = 0; k < K; k += 16) {
        const bf16x8 a = *(const bf16x8*)(arow + k + 8 * hi);
#pragma unroll
        for (int n = 0; n < N; ++n) { const bf16x8 b = *(const bf16x8*)(brow[n] + k + 8 * hi); acc[n] = MFMA32(a, b, acc[n]); }
    }
}

constexpr int CONV_SCR = 16896;
template <class F> __device__ __forceinline__ void transpose_item(const F& f, bf16* WT, int ldk, int n0, int k0, LAS float* scr, int lane) {
#pragma unroll
    for (int kk = 0; kk < 64; ++kk) scr[kk * 65 + lane] = f(k0 + kk, n0 + lane);
    asm volatile("s_waitcnt lgkmcnt(0)" ::: "memory");
    const int c = lane & 7;
#pragma unroll
    for (int j = 0; j < 8; ++j) { const int n = (lane >> 3) + 8 * j; const LAS float* s = scr + (8 * c) * 65 + n;
        u32x4 o; o.x = pk2(s[0 * 65], s[1 * 65]); o.y = pk2(s[2 * 65], s[3 * 65]); o.z = pk2(s[4 * 65], s[5 * 65]); o.w = pk2(s[6 * 65], s[7 * 65]);
        *(u32x4*)(WT + (size_t)(n0 + n) * ldk + k0 + 8 * c) = o; }
    asm volatile("s_waitcnt lgkmcnt(0)" ::: "memory");
}
template <class F> __device__ __forceinline__ void conv_matrix(const F& f, bf16* WT, int nrows, int kcols, LAS float* scr, int lane, int gw, int ngw, int& base) {
    const int nkb = kcols / 64, items = (nrows / 64) * nkb; int first = (gw - base) % ngw; if (first < 0) first += ngw;
    for (int it = first; it < items; it += ngw) transpose_item(f, WT, kcols, (it / nkb) * 64, (it % nkb) * 64, scr, lane);
    base += items;
}

__device__ __forceinline__ void sincos_acc(float ang, float& s, float& c) {
    const double x = (double)ang; const double kq = __builtin_rint(x * 0.63661977236758134308);
    double r = __builtin_fma(-kq, 1.57079632679489655800e+00, x); r = __builtin_fma(-kq, 6.12323399573676603587e-17, r);
    const double r2 = r * r;
    double sp = r * (1.0 + r2 * (-1.0 / 6 + r2 * (1.0 / 120 + r2 * (-1.0 / 5040 + r2 * (1.0 / 362880 + r2 * (-1.0 / 39916800 + r2 * (1.0 / 6227020800.0)))))));
    double cp = 1.0 + r2 * (-0.5 + r2 * (1.0 / 24 + r2 * (-1.0 / 720 + r2 * (1.0 / 40320 + r2 * (-1.0 / 3628800 + r2 * (1.0 / 479001600.0))))));
    const int q = ((int)kq) & 3;
    double ss = (q & 1) ? cp : sp, cc = (q & 1) ? sp : cp;
    if (q == 1) cc = -cc; else if (q == 2) { ss = -ss; cc = -cc; } else if (q == 3) ss = -ss;
    s = (float)ss; c = (float)cc;
}


namespace pg8 {
constexpr int BM = 256, BK = 64, HALF = 128, HTB = HALF * BK * 2, STAGE_BYTES = 8 * HTB;
__device__ __forceinline__ int lds_byte(int r, int c) { const int st = (r >> 4) * 2 + (c >> 5), rr = r & 15, cc = c & 31, ob = rr * 64 + cc * 2; return st * 1024 + (ob ^ (((ob >> 9) & 1) << 5)); }
__device__ __forceinline__ void stage_rc(int b, int& R, int& Cc) { const int st = b / 1024, sb = b % 1024, swz = sb ^ (((sb >> 9) & 1) << 5); R = (st >> 1) * 16 + swz / 64; Cc = (st & 1) * 32 + (swz % 64) / 2; }
__device__ __forceinline__ int perm32(int rho) { const int n = rho >> 4, i = rho & 15; return 8 * (i >> 2) + 4 * n + (i & 3); }
struct Unit { int pm, pn, nt, aux; const char* A; const char* B; };
template <bool GATHER, class Epi, class Sched> __device__ __forceinline__ void gemm_phase(LAS unsigned char* lds, const int tid_in, const int lda, const int ldb, const Sched& S, const Epi& E) {
    int tid_ = tid_in; asm volatile("" : "+v"(tid_));
    const int tid = tid_, wid = __builtin_amdgcn_readfirstlane(tid >> 6), lane = tid & 63, wr = wid >> 2, wc = wid & 3, fr = lane & 15, fq = lane >> 4;
    int RA[2], CA2[2]; unsigned voffB[2];
#pragma unroll
    for (int i = 0; i < 2; ++i) { int R, Cc; stage_rc(tid * 16 + i * 8192, R, Cc); RA[i] = R; CA2[i] = Cc * 2; const int Rb = (R & ~31) + perm32(R & 31); voffB[i] = (unsigned)(Rb * ldb + Cc * 2); }
    const size_t kstep = (size_t)(BK * 2); const size_t hstepB = (size_t)HALF * ldb;
    const unsigned ldsb = (unsigned)(uintptr_t)lds + (unsigned)wid * 1024u;
    const int aoff = lds_byte(wr * 64 + fr, fq * 8), boff = lds_byte(wc * 32 + fr, fq * 8);
#define PG8_SA(b, h) (((b) * 2 + (h)) * HTB)
#define PG8_SB(b, h) ((4 + (b) * 2 + (h)) * HTB)
#define PG8_STAGE(bufoff, gbase, voff) do { _Pragma("unroll") for (int _i = 0; _i < 2; ++_i) \
        glds16((const char*)(gbase), (voff)[_i], (unsigned)__builtin_amdgcn_readfirstlane(ldsb + (unsigned)((bufoff) + _i * 8192))); } while (0)
#define PG8_LDA(dst, b, h) do { _Pragma("unroll") for (int m = 0; m < 4; ++m) _Pragma("unroll") for (int k = 0; k < 2; ++k) dst[m][k] = *(const LAS bf16x8*)(lds + PG8_SA(b, h) + aoff + m * 2048 + k * 1024); } while (0)
#define PG8_LDB(dst, b, h) do { _Pragma("unroll") for (int n = 0; n < 2; ++n) _Pragma("unroll") for (int k = 0; k < 2; ++k) dst[n][k] = *(const LAS bf16x8*)(lds + PG8_SB(b, h) + boff + n * 2048 + k * 1024); } while (0)
#define PG8_MMA(ai, bj, At, Bt) do { __builtin_amdgcn_s_setprio(1); _Pragma("unroll") for (int m = 0; m < 4; ++m) _Pragma("unroll") for (int n = 0; n < 2; ++n) _Pragma("unroll") for (int k = 0; k < 2; ++k) \
        acc[ai][bj][m][n] = __builtin_amdgcn_mfma_f32_16x16x32_bf16(Bt[n][k], At[m][k], acc[ai][bj][m][n], 0, 0, 0); __builtin_amdgcn_s_setprio(0); } while (0)
#define PG8_WAIT_V(n) asm volatile("s_waitcnt vmcnt(" #n ")" ::: "memory")
#define PG8_WAIT_L(n) asm volatile("s_waitcnt lgkmcnt(" #n ")" ::: "memory")
#define PG8_BAR __builtin_amdgcn_s_barrier()
#define PG8_SCHED __builtin_amdgcn_sched_barrier(0)
    Unit cur, nxt; int ui = 0;
    if (!S.next(0, cur)) return;
    f32x4 acc[2][2][4][2];
#pragma unroll
    for (int a = 0; a < 2; ++a)
#pragma unroll
        for (int b = 0; b < 2; ++b)
#pragma unroll
            for (int m = 0; m < 4; ++m)
#pragma unroll
                for (int n = 0; n < 2; ++n) acc[a][b][m][n] = (f32x4){0.f, 0.f, 0.f, 0.f};
    bf16x8 At[4][2], B0[2][2], B1[2][2];
    unsigned va[2][2], nva[2][2];
    S.a_rows(cur, RA, CA2, lda, va);
    const char* cA = cur.A; const char* cB = cur.B;
    PG8_STAGE(PG8_SB(0, 0), cB, voffB); PG8_STAGE(PG8_SB(0, 1), cB + hstepB, voffB); PG8_STAGE(PG8_SA(0, 0), cA, va[0]); PG8_STAGE(PG8_SA(0, 1), cA, va[1]);
    if (wr == 1) PG8_BAR;
    PG8_WAIT_V(2); PG8_BAR;
    PG8_STAGE(PG8_SB(1, 0), cB + kstep, voffB); PG8_STAGE(PG8_SA(1, 0), cA + kstep, va[0]); PG8_STAGE(PG8_SB(1, 1), cB + hstepB + kstep, voffB);
    PG8_WAIT_V(6); PG8_BAR;
    for (;;) {
        const bool has_next = S.next(ui + 1, nxt);
        const char* nA = has_next ? nxt.A : cA; const char* nB = has_next ? nxt.B : cB;
        if (GATHER && has_next) S.a_rows(nxt, RA, CA2, lda, nva); else { nva[0][0] = va[0][0]; nva[0][1] = va[0][1]; nva[1][0] = va[1][0]; nva[1][1] = va[1][1]; }
        int nt_ = cur.nt; asm volatile("" : "+s"(nt_)); const int nt = nt_;
        for (int t = 0; t < nt; t += 2) {
            const bool last = (t == nt - 2);
            const char* a1 = cA + (size_t)(t + 1) * kstep;
            const char* a2 = last ? nA : cA + (size_t)(t + 2) * kstep; const char* b2 = last ? nB : cB + (size_t)(t + 2) * kstep;
            const char* a3 = a2 + kstep; const char* b3 = b2 + kstep;
            unsigned xv[2][2];
#pragma unroll
            for (int h = 0; h < 2; ++h)
#pragma unroll
                for (int i = 0; i < 2; ++i) xv[h][i] = (GATHER && last) ? nva[h][i] : va[h][i];
            PG8_LDB(B0, 0, 0); PG8_LDB(B1, 0, 1); PG8_SCHED; PG8_LDA(At, 0, 0); PG8_STAGE(PG8_SA(1, 1), a1, va[1]);
            PG8_WAIT_V(8); PG8_WAIT_L(0); PG8_BAR; PG8_MMA(0, 0, At, B0); PG8_MMA(0, 1, At, B1); PG8_BAR; PG8_SCHED;
            PG8_LDA(At, 0, 1); PG8_STAGE(PG8_SB(0, 0), b2, voffB); PG8_STAGE(PG8_SB(0, 1), b2 + hstepB, voffB); PG8_STAGE(PG8_SA(0, 0), a2, xv[0]);
            PG8_WAIT_V(8); PG8_WAIT_L(0); PG8_BAR; PG8_MMA(1, 0, At, B0); PG8_MMA(1, 1, At, B1); PG8_BAR; PG8_SCHED;
            PG8_LDB(B0, 1, 0); PG8_LDB(B1, 1, 1); PG8_SCHED; PG8_LDA(At, 1, 0); PG8_STAGE(PG8_SA(0, 1), a2, xv[1]);
            PG8_WAIT_V(8); PG8_WAIT_L(0); PG8_BAR; PG8_MMA(0, 0, At, B0); PG8_MMA(0, 1, At, B1); PG8_BAR; PG8_SCHED;
            PG8_LDA(At, 1, 1); PG8_STAGE(PG8_SB(1, 0), b3, voffB); PG8_STAGE(PG8_SB(1, 1), b3 + hstepB, voffB); PG8_STAGE(PG8_SA(1, 0), a3, xv[0]);
            PG8_WAIT_V(8); PG8_WAIT_L(0); PG8_BAR; PG8_MMA(1, 0, At, B0); PG8_MMA(1, 1, At, B1); PG8_BAR; PG8_SCHED;
        }
        if (wr == 0) PG8_BAR;
        { int tid_e = tid, fr_e = fr, fq_e = fq; asm volatile("" : "+v"(tid_e), "+v"(fr_e), "+v"(fq_e));
          E(acc, cur, tid_e, wr, wc, fr_e, fq_e); }
        if (!has_next) break;
#pragma unroll
        for (int a = 0; a < 2; ++a)
#pragma unroll
            for (int b = 0; b < 2; ++b)
#pragma unroll
                for (int m = 0; m < 4; ++m)
#pragma unroll
                    for (int n = 0; n < 2; ++n) acc[a][b][m][n] = (f32x4){0.f, 0.f, 0.f, 0.f};
        cur = nxt; cA = nA; cB = nB; ++ui;
#pragma unroll
        for (int h = 0; h < 2; ++h)
#pragma unroll
            for (int i = 0; i < 2; ++i) va[h][i] = nva[h][i];
        if (wr == 1) PG8_BAR;
    }
    PG8_WAIT_V(0);
    PG8_BAR;
#undef PG8_SA
#undef PG8_SB
#undef PG8_STAGE
#undef PG8_LDA
#undef PG8_LDB
#undef PG8_MMA
#undef PG8_WAIT_V
#undef PG8_WAIT_L
#undef PG8_BAR
#undef PG8_SCHED
}
struct PlainRows { __device__ __forceinline__ void a_rows(const Unit&, const int (&RA)[2], const int (&CA2)[2], int lda, unsigned (&va)[2][2]) const {
#pragma unroll
    for (int h = 0; h < 2; ++h)
#pragma unroll
        for (int i = 0; i < 2; ++i) va[h][i] = (unsigned)((h * HALF + RA[i]) * lda + CA2[i]); } };
}

struct GridSched : pg8::PlainRows {
    const char* A; const char* B; int nM, nN, nt, G, c, lda, ldb;
    __device__ __forceinline__ bool next(int i, pg8::Unit& u) const {
        const int nwg = nM * nN; const long L = (long)i * G + c; if (L >= nwg) return false;
        int wgid = (int)L; { const int q = nwg / 8, r = nwg % 8, xcd = wgid % 8, off = wgid / 8; wgid = (xcd < r ? xcd * (q + 1) : r * (q + 1) + (xcd - r) * q) + off; }
        const int nig = 8 * nN, gid = wgid / nig, fm = gid * 8, gsz = (nM - fm) < 8 ? (nM - fm) : 8;
        u.pm = fm + ((wgid % nig) % gsz); u.pn = (wgid % nig) / gsz; u.nt = nt; u.aux = 0;
        u.A = A + (size_t)u.pm * 256 * lda; u.B = B + (size_t)u.pn * 256 * ldb; return true; }
};
__device__ __forceinline__ u32x4 pack8(const f32x4& v0, const f32x4& v1) { u32x4 w; w.x = cvtpk(v0[0], v0[1]); w.y = cvtpk(v0[2], v0[3]); w.z = cvtpk(v1[0], v1[1]); w.w = cvtpk(v1[2], v1[3]); return w; }
struct EpiStoreBf16 { bf16* O; int ldc;
    __device__ __forceinline__ void operator()(const f32x4 (&acc)[2][2][4][2], const pg8::Unit& u, int tid, int wr, int wc, int fr, int fq) const {
        const int row0 = u.pm * 256 + wr * 64 + fr, col0 = u.pn * 256 + wc * 32 + 8 * fq;
#pragma unroll
        for (int ai = 0; ai < 2; ++ai)
#pragma unroll
            for (int m = 0; m < 4; ++m) { bf16* rowp = O + (size_t)(row0 + ai * 128 + m * 16) * ldc + col0;
#pragma unroll
                for (int bj = 0; bj < 2; ++bj) *(u32x4*)(rowp + bj * 128) = pack8(acc[ai][bj][m][0], acc[ai][bj][m][1]); } }
};
struct EpiResidBf16 { const bf16* X; bf16* Y; float alpha;
    __device__ __forceinline__ void operator()(const f32x4 (&acc)[2][2][4][2], const pg8::Unit& u, int tid, int wr, int wc, int fr, int fq) const {
        const int row0 = u.pm * 256 + wr * 64 + fr, col0 = u.pn * 256 + wc * 32 + 8 * fq;
#pragma unroll
        for (int ai = 0; ai < 2; ++ai)
#pragma unroll
            for (int m = 0; m < 4; ++m) { const size_t base = (size_t)(row0 + ai * 128 + m * 16) * DM + col0;
#pragma unroll
                for (int bj = 0; bj < 2; ++bj) { const u32x4 xw = *(const u32x4*)(X + base + bj * 128);
                    const f32x4 x0 = (f32x4){bflo(xw.x), bfhi(xw.x), bflo(xw.y), bfhi(xw.y)}, x1 = (f32x4){bflo(xw.z), bfhi(xw.z), bflo(xw.w), bfhi(xw.w)};
                    *(u32x4*)(Y + base + bj * 128) = pack8(x0 * alpha + acc[ai][bj][m][0], x1 * alpha + acc[ai][bj][m][1]); } } }
};

#define XB_TMO      128
#define XB_XCNT(j)  (256  + 64 * (j))
#define XB_XSUB(j)  (1280 + 64 * (j))
#define XB_XGEN(j)  (2304 + 64 * (j))
#define XB_TOP      3328
#define XB_TOPGEN   3392
#define XCD_BAR_WORDS 3456
#define XB_SPIN_CAP (1u << 18)

__device__ __forceinline__ unsigned xb_ld(unsigned* p)              { return __hip_atomic_load(p, __ATOMIC_RELAXED, __HIP_MEMORY_SCOPE_AGENT); }
__device__ __forceinline__ unsigned xb_add(unsigned* p, unsigned v) { return __hip_atomic_fetch_add(p, v, __ATOMIC_RELAXED, __HIP_MEMORY_SCOPE_AGENT); }
__device__ __forceinline__ unsigned xb_xcc_id() { return (unsigned)__builtin_amdgcn_s_getreg((3 << 11) | 20) & 0xFu; }
#define XB_SPIN(cond, bar) do { unsigned _sp = 0; while (cond) { __builtin_amdgcn_s_sleep(1); \
    if ((++_sp & 255u) == 0u) { if (xb_ld(&(bar)[XB_TMO])) break; if (_sp > XB_SPIN_CAP) { atomicAdd(&(bar)[XB_TMO], 1u); break; } } } } while (0)

struct XcdBarrier {
    unsigned wv; unsigned* bar; unsigned x;
    volatile LAS unsigned* st;
};

#define XB_IS_T0(b) ((b).wv == 0u && lane_id_asm() == 0)
__device__ __forceinline__ XcdBarrier xcd_barrier_post(unsigned* bar, volatile LAS unsigned* st, unsigned wv) {
    XcdBarrier b; b.wv = wv; b.bar = bar; b.x = xb_xcc_id(); b.st = st;
    if (XB_IS_T0(b)) (void)xb_add(&bar[XB_XCNT(b.x)], 1u);
    return b;
}
__device__ __forceinline__ void xcd_barrier_complete(unsigned* bar, unsigned x, unsigned& nloc, unsigned& nx) {
    const unsigned G = gridDim.x * gridDim.y * gridDim.z;
    unsigned sum, cnt, mine, sp = 0u;
    for (;;) {
        sum = 0u; cnt = 0u; mine = 0u;
#pragma unroll
        for (unsigned j = 0; j < 16; ++j) { const unsigned c = xb_ld(&bar[XB_XCNT(j)]); sum += c; cnt += (c > 0u) ? 1u : 0u; mine = (j == x) ? c : mine; }
        if (sum == G) break;
        __builtin_amdgcn_s_sleep(1);
        if ((++sp & 255u) == 0u) { if (xb_ld(&bar[XB_TMO])) break; if (sp > XB_SPIN_CAP) { atomicAdd(&bar[XB_TMO], 1u); break; } }
    }
    nloc = mine > 0u ? mine : 1u; nx = cnt > 0u ? cnt : 1u;
}

__device__ __forceinline__ void xcd_barrier(const XcdBarrier& b) {
    asm volatile("s_waitcnt vmcnt(0)" ::: "memory");
    __syncthreads();
    if (XB_IS_T0(b)) {
        unsigned* bar = b.bar;
        __builtin_amdgcn_s_waitcnt(0);
        unsigned nloc = b.st[0], nx = b.st[1];
        if (nloc == 0u) { xcd_barrier_complete(bar, b.x, nloc, nx); b.st[0] = nloc; b.st[1] = nx; }
        const unsigned old = xb_add(&bar[XB_XSUB(b.x)], 1u);
        const unsigned gen = old / nloc;
        if (old + 1u == (gen + 1u) * nloc) {
            __builtin_amdgcn_fence(__ATOMIC_RELEASE, "agent");
            asm volatile("s_waitcnt vmcnt(0)" ::: "memory");
            const unsigned og = xb_add(&bar[XB_TOP], 1u);
            const unsigned tg = og / nx;
            if (og + 1u == (tg + 1u) * nx) xb_add(&bar[XB_TOPGEN], 1u);
            else XB_SPIN(xb_ld(&bar[XB_TOPGEN]) == tg, bar);
            __builtin_amdgcn_fence(__ATOMIC_ACQUIRE, "agent");
            xb_add(&bar[XB_XGEN(b.x)], 1u);
            asm volatile("s_waitcnt vmcnt(0)" ::: "memory");
        } else {
            XB_SPIN(xb_ld(&bar[XB_XGEN(b.x)]) == gen, bar);
            __builtin_amdgcn_fence(__ATOMIC_ACQUIRE, "agent");
            asm volatile("s_waitcnt vmcnt(0)" ::: "memory");
        }
    }
    __syncthreads();
}

struct Ctx {
    float* hf; unsigned char* ws; LAS unsigned char* lds;
    int tid, lane, wave, gw, ngw, G;
};
#define WSP(type, off) ((type*)(C.ws + (off)))
__device__ __forceinline__ Ctx fresh(const Ctx& C0) { Ctx C = C0; int w = C.wave; asm volatile("" : "+s"(w)); C.wave = w; C.lane = lane_id_asm(); C.tid = w * 64 + C.lane; C.gw = blockIdx.x * NWAVES + w; return C; }

__device__ __forceinline__ void ln_row(f32x4 (&v)[4], const float* g, const float* b, float* hfrow, bf16* hbrow, int lane) {
    float s = 0.f;
#pragma unroll
    for (int j = 0; j < 4; ++j) s += (v[j].x + v[j].y) + (v[j].z + v[j].w);
    const float mean = wave_sum_l(s, lane) * (1.f / DM); float s2 = 0.f;
#pragma unroll
    for (int j = 0; j < 4; ++j) { v[j] = v[j] - mean; s2 += (v[j].x * v[j].x + v[j].y * v[j].y) + (v[j].z * v[j].z + v[j].w * v[j].w); }
    const float rstd = 1.f / sqrtf(wave_sum_l(s2, lane) * (1.f / DM) + LN_EPS);
#pragma unroll
    for (int j = 0; j < 2; ++j) { const int c = 8 * lane + 512 * j;
        v[2 * j] = v[2 * j] * rstd * *(const f32x4*)(g + c) + *(const f32x4*)(b + c); v[2 * j + 1] = v[2 * j + 1] * rstd * *(const f32x4*)(g + c + 4) + *(const f32x4*)(b + c + 4);
        if (hfrow) { *(f32x4*)(hfrow + c) = v[2 * j]; *(f32x4*)(hfrow + c + 4) = v[2 * j + 1]; }
        u32x4 o; o.x = pk2(v[2 * j].x, v[2 * j].y); o.y = pk2(v[2 * j].z, v[2 * j].w); o.z = pk2(v[2 * j + 1].x, v[2 * j + 1].y); o.w = pk2(v[2 * j + 1].z, v[2 * j + 1].w); *(u32x4*)(hbrow + c) = o; }
}
__device__ __forceinline__ void ld8bf(const bf16* p, f32x4& a, f32x4& b) { const u32x4 w = *(const u32x4*)p; a = (f32x4){bflo(w.x), bfhi(w.x), bflo(w.y), bfhi(w.y)}; b = (f32x4){bflo(w.z), bfhi(w.z), bflo(w.w), bfhi(w.w)}; }
__device__ __forceinline__ f32x4 ld4bf(const bf16* p) { const u32x2 w = *(const u32x2*)p; return (f32x4){bflo(w.x), bfhi(w.x), bflo(w.y), bfhi(w.y)}; }

__device__ __forceinline__ void ph_prologue(const Args& A, const Ctx& C0) { const Ctx C = fresh(C0);
    LAS float* scr = (LAS float*)(C.lds + C.wave * CONV_SCR); int cbase = 0;
    for (int l = 0; l < NL; ++l) {
        unsigned char* wb = C.ws + WS_WSM + l * WSM_STRIDE;
        { const float* W = A.in[4] + (size_t)l * DM * DIN;
          auto f = [W](int k, int n) -> float { int src; float sc = 1.f;
              if (n < 1792) { src = n; if (n < 256) sc = SC32; else if (n >= 768 && n < 1024) sc = SC64; }
              else if (n < 2560) { src = 1952 + (n - 1792); if (n < 2048) sc = SC64; }
              else if (n < 2688) src = 1792 + (n - 2560);
              else if (n < 2720) { const int i = n - 2688; src = 1920 + (i & 1) * 16 + (i >> 1); }
              else if (n < 2724) src = n;
              else return 0.f;
              return W[(size_t)k * DIN + src] * sc; };
          conv_matrix(f, (bf16*)(wb + WO_WIN), NPROJ, DM, scr, C.lane, C.gw, C.ngw, cbase); }
        { const float* W = A.in[13] + (size_t)l * 4 * DM * DM;
          auto f = [W](int k, int R) -> float { const int grp = R >> 8, j = R & 255, n = ((j >> 7) << 1) | ((j >> 2) & 1), c = grp * 64 + ((j >> 5) & 3) * 16 + ((j >> 3) & 3) * 4 + (j & 3); return W[((size_t)n * DM + k) * DM + c]; };
          conv_matrix(f, (bf16*)(wb + WO_WG), 4 * DM, DM, scr, C.lane, C.gw, C.ngw, cbase); }
        { const float* W = A.in[15] + (size_t)l * 4 * 256 * DM;
          auto f = [W](int k, int n) -> float { return W[(size_t)k * DM + n]; };
          conv_matrix(f, (bf16*)(wb + WO_WB), DM, DM, scr, C.lane, C.gw, C.ngw, cbase); }
        { const float* W = A.in[16] + (size_t)l * DM * DM;
          auto f = [W](int k, int n) -> float { return W[(size_t)k * DM + n]; };
          conv_matrix(f, (bf16*)(wb + WO_WO), DM, DM, scr, C.lane, C.gw, C.ngw, cbase); }
        { const float* W = A.in[11] + (size_t)l * 256 * 384; const float* g = A.in[9] + l * 256;
          auto f = [W, g](int k, int n) -> float { if (n >= 384) return 0.f; const int h = n / 96, d = n % 96; int src = n;
              if (d >= 64) { const int i = d - 64; src = h * 96 + 64 + (i & 1) * 16 + (i >> 1); }
              return W[(size_t)k * 384 + src] * g[k] * SC96; };
          conv_matrix(f, (bf16*)(wb + WO_WUQ), 512, 256, scr, C.lane, C.gw, C.ngw, cbase); }
        { const float* W = A.in[12] + (size_t)l * 128 * 512; const float* g = A.in[10] + l * 128;
          auto f = [W, g](int k, int n) -> float { if (k >= 128) return 0.f; const int src = (n < 256) ? ((n >> 6) * 128 + (n & 63)) : (((n - 256) >> 6) * 128 + 64 + (n & 63));
              return W[(size_t)k * 512 + src] * g[k]; };
          conv_matrix(f, (bf16*)(wb + WO_WUKV), 512, 256, scr, C.lane, C.gw, C.ngw, cbase); }
    }
    { float* rope = WSP(float, WS_MISC + MO_ROPE); const int gt = C.gw * 64 + C.lane, ngt = C.ngw * 64;
      for (int i = gt; i < SEQ * 16; i += ngt) { const int pos = i >> 4, f = i & 15;
          const float invf = powf(10000.0f, -(float)f * 2.0f / 32.0f); const float ang = (float)pos * invf; float s, c; sincos_acc(ang, s, c);
          rope[2 * i] = c; rope[2 * i + 1] = s; }
      float* bt = WSP(float, WS_MISC + MO_T5);
      for (int i = gt; i < NL * 2 * 4 * 320; i += ngt) { const int rel = (i % 320) - 256, h = (i / 320) & 3, ty = (i / 1280) & 1, l = i / 2560; float v;
          if (ty == 0) { const int n = rel < 0 ? -rel : rel; int bk;
              if (n < 8) bk = n; else if (n < 12) bk = 8; else if (n < 16) bk = 9; else if (n < 23) bk = 10; else if (n < 32) bk = 11; else if (n < 46) bk = 12; else if (n < 64) bk = 13; else if (n < 91) bk = 14; else bk = 15;
              if (rel > 0) bk += 16;
              v = A.in[3][bk * 4 + h] - A.in[3][15 * 4 + h]; }
          else { const int rc = rel < -128 ? -128 : rel; const float* rb = A.in[8] + (size_t)l * 257 * 4; v = rb[(rc + 128) * 4 + h] - rb[h]; }
          bt[i] = v * LOG2E; } }
    { float* wrt = WSP(float, WS_MISC + MO_WRT); const int gt = C.gw * 64 + C.lane, ngt = C.ngw * 64;
      for (int i = gt; i < NL * 36 * DM; i += ngt) { const int k = i & (DM - 1), e = (i >> 10) % 36, l = i / (36 * DM);
          wrt[i] = e < 4 ? A.in[19][((size_t)l * DM + k) * 4 + e] : A.in[21][((size_t)l * DM + k) * 32 + (e - 4)]; } }
    bf16* hb = WSP(bf16, WS_HB);
    for (int m = 2 * C.gw; m < NT; m += 2 * C.ngw) { f32x4 v[2][4];
#pragma unroll
        for (int r = 0; r < 2; ++r)
#pragma unroll
            for (int j = 0; j < 4; ++j) v[r][j] = *(const f32x4*)(A.in[0] + (size_t)(m + r) * DM + 8 * C.lane + 512 * (j >> 1) + 4 * (j & 1));
#pragma unroll
        for (int r = 0; r < 2; ++r) ln_row(v[r], A.in[1], A.in[2], nullptr, hb + (size_t)(m + r) * DM, C.lane); }
}

__device__ __forceinline__ float log_sigmoid(float x) { return fminf(x, 0.f) - log1pf(expf(-fabsf(x))); }
struct EpiProj { bf16* O; float* rstd; const float* rope; bf16* mk; float* sum64; const float* bfg; LAS float* xl;
    __device__ __forceinline__ void operator()(const f32x4 (&acc)[2][2][4][2], const pg8::Unit& u, int tid, int wr, int wc, int fr, int fq) const {
        const int row0 = u.pm * 256 + wr * 64 + fr, col0 = u.pn * 256 + wc * 32 + 8 * fq; const int lane = tid & 63;
        const bool stat = (u.pn == 6 || u.pn == 10);
        float ssq[2][4];
#pragma unroll
        for (int ai = 0; ai < 2; ++ai)
#pragma unroll
            for (int m = 0; m < 4; ++m) { bf16* rowp = O + (size_t)(row0 + ai * 128 + m * 16) * NPROJ + col0; float q = 0.f;
#pragma unroll
                for (int bj = 0; bj < 2; ++bj) { const u32x4 w = pack8(acc[ai][bj][m][0], acc[ai][bj][m][1]); *(u32x4*)(rowp + bj * 128) = w;
                    if (stat && (u.pn == 6 || bj == 0)) q += (bflo(w.x) * bflo(w.x) + bfhi(w.x) * bfhi(w.x)) + (bflo(w.y) * bflo(w.y) + bfhi(w.y) * bfhi(w.y)) + (bflo(w.z) * bflo(w.z) + bfhi(w.z) * bfhi(w.z)) + (bflo(w.w) * bflo(w.w) + bfhi(w.w) * bfhi(w.w));
                    if (u.pn == 10 && bj == 1) {
                        if (wc == 0) {
                            const int row = row0 + ai * 128 + m * 16, pos = row & (SEQ - 1); const float* rp = rope + ((size_t)pos * 16 + 4 * fq) * 2; const f32x4 ra = *(const f32x4*)rp, rb = *(const f32x4*)(rp + 4);
                            const f32x4 t0 = {bflo(w.x), bfhi(w.x), bflo(w.y), bfhi(w.y)}, t1 = {bflo(w.z), bfhi(w.z), bflo(w.w), bfhi(w.w)};
                            const f32x4 r0 = {t0[0] * ra[0] - t0[1] * ra[1], t0[0] * ra[1] + t0[1] * ra[0], t0[2] * ra[2] - t0[3] * ra[3], t0[2] * ra[3] + t0[3] * ra[2]};
                            const f32x4 r1 = {t1[0] * rb[0] - t1[1] * rb[1], t1[0] * rb[1] + t1[1] * rb[0], t1[2] * rb[2] - t1[3] * rb[3], t1[2] * rb[3] + t1[3] * rb[2]};
                            const u32x4 ow = pack8(r0, r1);
#pragma unroll
                            for (int h = 0; h < 4; ++h) *(u32x4*)(mk + (size_t)row * 384 + h * 96 + 64 + 8 * fq) = ow; } } }
                ssq[ai][m] = q; }
        if (u.pn == 10 && wc == 1) {
#pragma unroll
            for (int ai = 0; ai < 2; ++ai) { f32x4 sm = {0.f, 0.f, 0.f, 0.f};
#pragma unroll
                for (int m = 0; m < 4; ++m) { const u32x4 w = pack8(acc[ai][1][m][0], acc[ai][1][m][1]); const float x[4] = {bflo(w.x), bfhi(w.x), bflo(w.y), bfhi(w.y)};
#pragma unroll
                    for (int h = 0; h < 4; ++h) sm[h] += log_sigmoid(x[h] + bfg[h]) * LOG2E; }
#pragma unroll
                for (int h = 0; h < 4; ++h) {
#pragma unroll
                    for (int o = 1; o < 16; o <<= 1) sm[h] += shfl_xor_l(sm[h], o, lane); }
                if (lane == 0) *(f32x4*)(sum64 + (size_t)((u.pm * 2 + ai) * 2 + wr) * 4) = sm; } }
        if (stat) {
#pragma unroll
            for (int ai = 0; ai < 2; ++ai)
#pragma unroll
                for (int m = 0; m < 4; ++m) { float q = ssq[ai][m]; q += shfl_xor_l(q, 16, lane); q += shfl_xor_l(q, 32, lane); if (fq == 0) xl[wc * 256 + ai * 128 + wr * 64 + m * 16 + fr] = q; }
            asm volatile("s_waitcnt lgkmcnt(0)\n\ts_barrier" ::: "memory");
            if (tid < 256) { const float t = (xl[tid] + xl[256 + tid]) + (xl[512 + tid] + xl[768 + tid]);
                if (u.pn == 6) rstd[2 * (u.pm * 256 + tid)] = 1.f / sqrtf(t * (1.f / 256) + LN_EPS); else rstd[2 * (u.pm * 256 + tid) + 1] = 1.f / sqrtf(t * (1.f / 128) + LN_EPS); }
            asm volatile("s_waitcnt lgkmcnt(0)\n\ts_barrier" ::: "memory"); }
    }
};
__device__ __forceinline__ void ph_proj(const Args& A, const Ctx& C0, int l) { const Ctx C = fresh(C0);
    GridSched S; S.A = (const char*)WSP(bf16, WS_HB); S.B = (const char*)WSP(bf16, WS_WSM + l * WSM_STRIDE + WO_WIN); S.nM = NT / 256; S.nN = NPROJ / 256; S.nt = DM / 64; S.G = C.G; S.c = blockIdx.x; S.lda = DM * 2; S.ldb = DM * 2;
    EpiProj E{WSP(bf16, WS_R1), WSP(float, WS_MISC + MO_RSTD), WSP(float, WS_MISC + MO_ROPE), WSP(bf16, WS_R2 + 24 * MiB), WSP(float, WS_MISC + MO_SUM64), A.in[5] + l * 4, (LAS float*)(C.lds + LDS_TAB)};
    pg8::gemm_phase<false>(C.lds, C.tid, DM * 2, DM * 2, S, E);
}

__device__ __forceinline__ void fox_tables(const Args& A, const Ctx& C, int l) {
    const bf16* proj = WSP(bf16, WS_R1); const float* sum64 = WSP(float, WS_MISC + MO_SUM64); float* cum = WSP(float, WS_MISC + MO_CUM); const float* bf = A.in[5] + l * 4;
    LAS float* wt = (LAS float*)(C.lds + LDS_TAB);
    for (int blk = blockIdx.x; blk < NT / 128; blk += C.G) { const int b = blk / (SEQ / 128);
        __syncthreads();
        if (C.tid < 128) { const int idx = b * (SEQ / 64) + C.tid; f32x4 p = idx < blk * 2 ? *(const f32x4*)(sum64 + (size_t)idx * 4) : (f32x4){0.f, 0.f, 0.f, 0.f};
#pragma unroll
            for (int h = 0; h < 4; ++h) p[h] = wave_sum_l(p[h], C.lane);
            if (C.lane == 0) *(LAS f32x4*)(wt + C.wave * 4) = p; }
        float ls[4] = {0.f, 0.f, 0.f, 0.f}, inc[4];
        if (C.tid < 128) { const u32x2 ff = *(const u32x2*)(proj + (size_t)(blk * 128 + C.tid) * NPROJ + PC_FF); const float x[4] = {bflo(ff.x), bfhi(ff.x), bflo(ff.y), bfhi(ff.y)};
#pragma unroll
            for (int h = 0; h < 4; ++h) ls[h] = log_sigmoid(x[h] + bf[h]) * LOG2E; }
#pragma unroll
        for (int h = 0; h < 4; ++h) { float v = ls[h];
#pragma unroll
            for (int o = 1; o < 64; o <<= 1) { const float y = shfl_up_l(v, o, C.lane); if (C.lane >= o) v += y; }
            inc[h] = v; if (C.tid == 63) wt[8 + h] = v; }
        __syncthreads();
        if (C.tid < 128) { const int t = (blk * 128 + C.tid) & (SEQ - 1);
#pragma unroll
            for (int h = 0; h < 4; ++h) cum[(size_t)(b * 4 + h) * SEQ + t] = (wt[h] + wt[4 + h]) + (C.wave == 1 ? wt[8 + h] : 0.f) + inc[h]; }
        float mq2 = 0.f, mk2 = 0.f;
        for (int i = 0; i < 16; ++i) { const bf16* row = proj + (size_t)(blk * 128 + C.wave * 16 + i) * NPROJ;
            const u32x2 fq = *(const u32x2*)(row + PC_FQ + 4 * C.lane), fk = *(const u32x2*)(row + PC_FK + 4 * C.lane);
            float a = bflo(fq.x) * bflo(fq.x) + bfhi(fq.x) * bfhi(fq.x) + bflo(fq.y) * bflo(fq.y) + bfhi(fq.y) * bfhi(fq.y);
            float b2 = bflo(fk.x) * bflo(fk.x) + bfhi(fk.x) * bfhi(fk.x) + bflo(fk.y) * bflo(fk.y) + bfhi(fk.y) * bfhi(fk.y);
#pragma unroll
            for (int o = 1; o < 16; o <<= 1) { a += shfl_xor_l(a, o, C.lane); b2 += shfl_xor_l(b2, o, C.lane); }
            mq2 = fmaxf(mq2, a); mk2 = fmaxf(mk2, b2); }
        unsigned* qkm = WSP(unsigned, WS_CTL) + CW_QKMAX + l * 32;
        if ((C.lane & 15) == 0) { atomicMax(qkm + b * 4 + (C.lane >> 4), __float_as_uint(mq2)); atomicMax(qkm + 16 + b * 4 + (C.lane >> 4), __float_as_uint(mk2)); }
    }
    __syncthreads();
}

struct MlaSched : pg8::PlainRows { const char* proj; const char* Wq; const char* Wkv; int G, c;
    __device__ __forceinline__ bool next(int i, pg8::Unit& u) const { const int cx = (G & 7) == 0 ? (c & 7) * (G >> 3) + (c >> 3) : c; const int L = i * G + cx; if (L >= (NT / 256) * 4) return false;
        const int pm = L >> 2, kind = (L >> 1) & 1, pn = L & 1; u.pm = pm; u.pn = pn; u.nt = 4; u.aux = kind;
        u.A = proj + (size_t)pm * 256 * (NPROJ * 2) + (kind ? PC_CKV : PC_CQ) * 2; u.B = (kind ? Wkv : Wq) + (size_t)pn * 256 * 512; return true; } };
struct EpiMla { const float* rstd; const float* rope; bf16* mq; bf16* mk; bf16* mv;
    __device__ __forceinline__ void operator()(const f32x4 (&acc)[2][2][4][2], const pg8::Unit& u, int tid, int wr, int wc, int fr, int fq) const {
        const int row0 = u.pm * 256 + wr * 64 + fr;
        if (u.aux == 0) {
#pragma unroll
            for (int ai = 0; ai < 2; ++ai)
#pragma unroll
                for (int m = 0; m < 4; ++m) { asm volatile("" ::: "memory"); const int row = row0 + ai * 128 + m * 16; const float rs = rstd[2 * row]; const int pos = row & (SEQ - 1);
#pragma unroll
                    for (int bj = 0; bj < 2; ++bj) { const int col0 = u.pn * 256 + bj * 128 + wc * 32 + 8 * fq; f32x4 v0 = acc[ai][bj][m][0] * rs, v1 = acc[ai][bj][m][1] * rs;
                        if (col0 < 384) { const int d0 = col0 % 96;
                            if (d0 >= 64) { const float* rp = rope + ((size_t)pos * 16 + ((d0 - 64) >> 1)) * 2; const f32x4 ra = *(const f32x4*)rp, rb = *(const f32x4*)(rp + 4);
                                const f32x4 t0 = v0, t1 = v1;
                                v0[0] = t0[0] * ra[0] - t0[1] * ra[1]; v0[1] = t0[0] * ra[1] + t0[1] * ra[0]; v0[2] = t0[2] * ra[2] - t0[3] * ra[3]; v0[3] = t0[2] * ra[3] + t0[3] * ra[2];
                                v1[0] = t1[0] * rb[0] - t1[1] * rb[1]; v1[1] = t1[0] * rb[1] + t1[1] * rb[0]; v1[2] = t1[2] * rb[2] - t1[3] * rb[3]; v1[3] = t1[2] * rb[3] + t1[3] * rb[2]; }
                            *(u32x4*)(mq + (size_t)row * 384 + col0) = pack8(v0, v1); } } }
        } else {
#pragma unroll
            for (int ai = 0; ai < 2; ++ai)
#pragma unroll
                for (int m = 0; m < 4; ++m) { asm volatile("" ::: "memory"); const int row = row0 + ai * 128 + m * 16; const float rs = rstd[2 * row + 1];
#pragma unroll
                    for (int bj = 0; bj < 2; ++bj) { const int col0 = u.pn * 256 + bj * 128 + wc * 32 + 8 * fq; const f32x4 v0 = acc[ai][bj][m][0] * rs, v1 = acc[ai][bj][m][1] * rs;
                        if (col0 < 256) *(u32x4*)(mk + (size_t)row * 384 + (col0 >> 6) * 96 + (col0 & 63)) = pack8(v0, v1); else *(u32x4*)(mv + (size_t)row * 256 + (col0 - 256)) = pack8(v0, v1); } }
        } }
};
__device__ __forceinline__ void ph_mla_up(const Args& A, const Ctx& C0, int l) { const Ctx C = fresh(C0);
    fox_tables(A, C, l);
    MlaSched S; S.proj = (const char*)WSP(bf16, WS_R1); S.Wq = (const char*)WSP(bf16, WS_WSM + l * WSM_STRIDE + WO_WUQ); S.Wkv = (const char*)WSP(bf16, WS_WSM + l * WSM_STRIDE + WO_WUKV); S.G = C.G; S.c = blockIdx.x;
    EpiMla E{WSP(float, WS_MISC + MO_RSTD), WSP(float, WS_MISC + MO_ROPE), WSP(bf16, WS_R2), WSP(bf16, WS_R2 + 24 * MiB), WSP(bf16, WS_R2 + 48 * MiB)};
    pg8::gemm_phase<false>(C.lds, C.tid, NPROJ * 2, 512, S, E);
}

typedef short s16x4 __attribute__((ext_vector_type(4)));
typedef __attribute__((address_space(3))) const char* lds_cptr;
constexpr int AT_K = 0, AT_KSLOT = 16384, AT_V = 49152, AT_VSLOT = 8192, AT_TAB = 81920, AT_CK = 83968;
constexpr float AT_THR = 8.f;
__device__ __forceinline__ s16x4 vtr(lds_cptr p) { return __builtin_bit_cast(s16x4, __builtin_amdgcn_ds_read_tr16_b64_v4i16((__attribute__((address_space(3))) s16x4*)p)); }
__device__ __forceinline__ float swapmax(float m) { auto rr = __builtin_amdgcn_permlane32_swap(__float_as_uint(m), __float_as_uint(m), false, false); return fmaxf(__uint_as_float(rr[0]), __uint_as_float(rr[1])); }
__device__ __forceinline__ float swapsum(float m) { auto rr = __builtin_amdgcn_permlane32_swap(__float_as_uint(m), __float_as_uint(m), false, false); return __uint_as_float(rr[0]) + __uint_as_float(rr[1]); }
#define AT_WAITBAR(N) asm volatile("s_waitcnt vmcnt(" #N ") lgkmcnt(0)\n\ts_barrier" ::: "memory")
#define MX3(a, b, c) __builtin_fmaxf(__builtin_fmaxf((a), (b)), (c))

struct AttnSrc { const bf16* Q; const bf16* K; const bf16* V; int qp, kp, vp; };

template <int TYPE> __device__ __forceinline__ void attn_unit(const Ctx& C, const AttnSrc& S, int qb, const float* gtab, const float* cumT, bf16* Odst, float lam_full, float lam_init, const float* dng, float bqk) {
    constexpr int DQ = TYPE == 2 ? 96 : 64, NMAP = TYPE == 0 ? 2 : 1, DMAP = DQ / NMAP, NKS = DMAP / 16;
    int lane_ = C.lane, wid_ = C.wave; asm volatile("" : "+v"(lane_), "+s"(wid_));
    const int lane = lane_, r32 = lane & 31, hi = lane >> 5, wid = wid_;
    const int q0 = qb * 256, qw = q0 + wid * 32, q = qw + r32, cw = qw >> 6;
    const int thi = 4 * qb + 3, thi_w = cw; const bool lag = wid >= 4;
    int tlo = TYPE == 1 ? (4 * qb - 8 > 0 ? 4 * qb - 8 : 0) : 0, tlo_w = TYPE == 1 ? (cw - 8 > 0 ? cw - 8 : 0) : 0;
    if (TYPE == 3) {
        const float d0 = cumT[q0] + 2.f * bqk + 40.f; const int t0 = lane, t1 = 64 + lane;
        const bool ok0 = (t0 <= thi) && (d0 - cumT[t0 * 64 + 63] >= 0.f), ok1 = (t1 <= thi) && (d0 - cumT[t1 * 64 + 63] >= 0.f);
        const unsigned long long m0 = __ballot(ok0), m1 = __ballot(ok1);
        tlo = m0 ? (int)__builtin_ctzll(m0) : (m1 ? 64 + (int)__builtin_ctzll(m1) : thi); tlo = __builtin_amdgcn_readfirstlane(tlo); if (tlo > 4 * qb) tlo = 4 * qb; tlo_w = tlo; }
    const unsigned lds0 = (unsigned)(uintptr_t)C.lds;
    LAS float* tab = (LAS float*)(C.lds + AT_TAB); LAS float* ckl = (LAS float*)(C.lds + AT_CK);
    const unsigned koff = (unsigned)(lane * S.kp + wid * 8) * 2u, voffv = (unsigned)((16 * (wid & 3) + (lane >> 2)) * S.vp + (wid >> 2) * 32 + (lane & 3) * 8) * 2u;
    const int k2 = (wid < 4 ? 8 : 4) * 16;
    const unsigned kdst = lds0 + AT_K + wid * 1024, vdst = lds0 + AT_V + wid * 1024;
#define AT_ISSUE_K(t, ks) do { const char* kb_ = (const char*)S.K + (size_t)(t) * 128 * S.kp; \
        glds16(kb_, koff, (unsigned)__builtin_amdgcn_readfirstlane(kdst + (ks) * AT_KSLOT)); \
        if (TYPE == 2) glds16(kb_ + k2, koff, (unsigned)__builtin_amdgcn_readfirstlane(kdst + (ks) * AT_KSLOT + 8192)); } while (0)
#define AT_ISSUE_V(t, vs) glds16((const char*)S.V + (size_t)(t) * 128 * S.vp, voffv, (unsigned)__builtin_amdgcn_readfirstlane(vdst + (vs) * AT_VSLOT))
    constexpr bool KPIPE = false, FOLD = true;
    AT_ISSUE_K(tlo, 0); AT_ISSUE_V(tlo, 0);
    if (tlo + 1 <= thi) { AT_ISSUE_K(tlo + 1, 1); AT_ISSUE_V(tlo + 1, 1); }
    if (KPIPE && tlo + 2 <= thi) AT_ISSUE_K(tlo + 2, 2);
    bf16x8 qr[NMAP][NKS];
#pragma unroll
    for (int m = 0; m < NMAP; ++m)
#pragma unroll
        for (int d0 = 0; d0 < NKS; ++d0) qr[m][d0] = *(const bf16x8*)(S.Q + (size_t)q * S.qp + m * DMAP + d0 * 16 + hi * 8);
    const int tid = wid * 64 + lane;
    if (TYPE == 0 || TYPE == 1) { if (tid < 320) tab[tid] = gtab[tid]; }
    float cq = 0.f;
    if (TYPE == 3) { for (int i = tid; i < q0 + 256 - tlo * 64; i += NTHR) ckl[i] = cumT[tlo * 64 + i]; cq = cumT[q]; }
    f32x16 o[NMAP][2], negm; float mhat = 0.f, lsum[NMAP]; u32x4 pw[NMAP][4];
#pragma unroll
    for (int r = 0; r < 16; ++r) negm[r] = cq;
#pragma unroll
    for (int m = 0; m < NMAP; ++m) { o[m][0] = f32x16{}; o[m][1] = f32x16{}; lsum[m] = 0.f;
#pragma unroll
        for (int i = 0; i < 4; ++i) pw[m][i] = (u32x4){0u, 0u, 0u, 0u}; }
#pragma unroll
    for (int m = 0; m < NMAP; ++m)
#pragma unroll
        for (int d0 = 0; d0 < NKS; ++d0) asm volatile("" : "+v"(qr[m][d0]));
    asm volatile("" : "+v"(cq));
    const lds_cptr kp0 = (lds_cptr)C.lds + AT_K + hi * 1024 + r32 * 16;
    const lds_cptr vp0 = (lds_cptr)C.lds + AT_V + ((lane >> 4) & 1) * 32 + (lane & 3) * 8 + (4 * hi + ((lane & 15) >> 2)) * 64;
    s16x4 vl[8], vh[8];
#define AT_VLOAD(vs_, i0, i1) do { const lds_cptr vp_ = vp0 + (vs_) * AT_VSLOT; \
        _Pragma("unroll") for (int i_ = (i0); i_ < (i1); ++i_) { vl[i_] = vtr(vp_ + ((i_ >> 2) * 4096 + (i_ & 3) * 1024)); vh[i_] = vtr(vp_ + ((i_ >> 2) * 4096 + (i_ & 3) * 1024 + 512)); } } while (0)
#define AT_VF(i_) (bf16x8){vl[i_][0], vl[i_][1], vl[i_][2], vl[i_][3], vh[i_][0], vh[i_][1], vh[i_][2], vh[i_][3]}
#define AT_PV(m, ALT) do { __builtin_amdgcn_s_setprio(1); \
        if (ALT) { _Pragma("unroll") for (int ks_ = 0; ks_ < 4; ++ks_) { o[m][0] = MFMA32(AT_VF(ks_), __builtin_bit_cast(bf16x8, pw[m][ks_]), o[m][0]); o[m][1] = MFMA32(AT_VF(4 + ks_), __builtin_bit_cast(bf16x8, pw[m][ks_]), o[m][1]); } } \
        else { _Pragma("unroll") for (int ks_ = 0; ks_ < 4; ++ks_) o[m][0] = MFMA32(AT_VF(ks_), __builtin_bit_cast(bf16x8, pw[m][ks_]), o[m][0]); \
               _Pragma("unroll") for (int ks_ = 0; ks_ < 4; ++ks_) o[m][1] = MFMA32(AT_VF(4 + ks_), __builtin_bit_cast(bf16x8, pw[m][ks_]), o[m][1]); } \
        __builtin_amdgcn_s_setprio(0); } while (0)
    int ks = 0, vs = 0, vprev = 0; bool pend = false;
    bf16x8 kf[1][NKS][2];
#define AT_KLOAD(ks_) do { const lds_cptr kp_ = kp0 + (ks_) * AT_KSLOT; \
        _Pragma("unroll") for (int d0 = 0; d0 < NKS; ++d0) { const int cb = d0 * 2048; \
            kf[0][d0][0] = *(const __attribute__((address_space(3))) bf16x8*)(kp_ + cb); kf[0][d0][1] = *(const __attribute__((address_space(3))) bf16x8*)(kp_ + cb + 512); } } while (0)
    if (KPIPE) { AT_WAITBAR(0);
        if (tlo_w == tlo) AT_KLOAD(0); }
    for (int t = tlo; t <= thi; ++t) {
        if (!KPIPE || t > tlo) { if (t + 1 <= thi) { if (TYPE == 2) AT_WAITBAR(3); else AT_WAITBAR(2); } else AT_WAITBAR(0); }
        if (KPIPE) { if (t + 3 <= thi) AT_ISSUE_K(t + 3, ks); }
        else if (t + 2 <= thi) AT_ISSUE_K(t + 2, ks >= 1 ? ks - 1 : 2);
        if (t + 2 <= thi) AT_ISSUE_V(t + 2, (vs + 2) & 3);
        if (pend) { AT_VLOAD(vprev, 0, 8); AT_PV(NMAP - 1, true); pend = false; }
        const int ksn = ks == 2 ? 0 : ks + 1;
        if (t >= tlo_w && t <= thi_w) {
            const bool first = (t == tlo_w);
#pragma unroll
            for (int m = 0; m < NMAP; ++m) {
                const bool pvnow = !lag || m < NMAP - 1;
                __builtin_amdgcn_sched_barrier(0);
                f32x16 s0 = FOLD ? negm : f32x16{}, s1 = FOLD ? negm : f32x16{};
                if (!KPIPE) { const lds_cptr kp_ = kp0 + ks * AT_KSLOT;
#pragma unroll
                    for (int d0 = 0; d0 < NKS; ++d0) { const int cb = (m * NKS + d0) * 2048;
                        kf[0][d0][0] = *(const __attribute__((address_space(3))) bf16x8*)(kp_ + cb); kf[0][d0][1] = *(const __attribute__((address_space(3))) bf16x8*)(kp_ + cb + 512); }
                    if (pvnow) AT_VLOAD(vs, 0, 4);
                    __builtin_amdgcn_sched_barrier(0); }
                __builtin_amdgcn_s_setprio(1);
#pragma unroll
                for (int d0 = 0; d0 < NKS; ++d0) { s0 = MFMA32(kf[0][d0][0], qr[m][d0], s0); s1 = MFMA32(kf[0][d0][1], qr[m][d0], s1); }
                __builtin_amdgcn_s_setprio(0);
                if (KPIPE) { if (pvnow) AT_VLOAD(vs, 0, 4);
                    if (t + 1 <= thi_w) AT_KLOAD(ksn); }
                if (TYPE == 0 || TYPE == 1) { if (t * 64 + 63 - qw > -128) { const LAS float* tb = tab + (t * 64 - q + 256);
#pragma unroll
                    for (int r = 0; r < 16; ++r) { s0[r] += tb[crow(r, hi)]; s1[r] += tb[32 + crow(r, hi)]; } } }
                if (TYPE == 3) { const LAS float* cb = ckl + (t - tlo) * 64 + 4 * hi;
#pragma unroll
                    for (int g = 0; g < 4; ++g) { const f32x4 c0 = *(const LAS f32x4*)(cb + 8 * g), c1 = *(const LAS f32x4*)(cb + 32 + 8 * g);
#pragma unroll
                        for (int i = 0; i < 4; ++i) { s0[4 * g + i] -= c0[i]; s1[4 * g + i] -= c1[i]; } }
                    if (t == cw) { const int kb = t * 64 + 4 * hi;
#pragma unroll
                        for (int r = 0; r < 16; ++r) { const int kv = kb + (r & 3) + 8 * (r >> 2); if (kv > q) s0[r] = -INFINITY; if (kv + 32 > q) s1[r] = -INFINITY; } } }
                float ra = MX3(s0[0], s0[1], s1[0]), rb = MX3(s0[2], s0[3], s1[1]); ra = MX3(ra, s1[2], s1[3]);
#pragma unroll
                for (int r = 4; r < 16; r += 4) { ra = MX3(ra, s0[r], s0[r + 1]); rb = MX3(rb, s0[r + 2], s0[r + 3]); ra = MX3(ra, s1[r], s1[r + 1]); rb = MX3(rb, s1[r + 2], s1[r + 3]); }
                const float rm = swapmax(fmaxf(ra, rb)) - (FOLD ? 0.f : mhat - cq);
                const bool fst = first && m == 0;
                if (fst || __any(rm > AT_THR)) { const float dl = fst ? rm : fmaxf(rm, 0.f); mhat += dl;
                    if (FOLD) {
#pragma unroll
                        for (int r = 0; r < 16; ++r) { s0[r] -= dl; s1[r] -= dl; negm[r] = cq - mhat; } }
                    if (!fst) { const float f = exp2f(-dl);
#pragma unroll
                        for (int mm = 0; mm < NMAP; ++mm) { lsum[mm] *= f;
#pragma unroll
                            for (int r = 0; r < 16; ++r) { o[mm][0][r] *= f; o[mm][1][r] *= f; } } } }
                float sacc = 0.f; const float sh = FOLD ? 0.f : mhat - cq;
#pragma unroll
                for (int r = 0; r < 16; ++r) { s0[r] = __builtin_amdgcn_exp2f(FOLD ? s0[r] : s0[r] - sh); s1[r] = __builtin_amdgcn_exp2f(FOLD ? s1[r] : s1[r] - sh); sacc += s0[r] + s1[r]; }
                lsum[m] += sacc;
                if (pvnow) AT_VLOAD(vs, 4, 8);
#pragma unroll
                for (int i = 0; i < 4; ++i) { pw[m][0][i] = cvtpk_dep(s0[2 * i], s0[2 * i + 1], sacc); pw[m][1][i] = cvtpk_dep(s0[8 + 2 * i], s0[8 + 2 * i + 1], sacc); pw[m][2][i] = cvtpk_dep(s1[2 * i], s1[2 * i + 1], sacc); pw[m][3][i] = cvtpk_dep(s1[8 + 2 * i], s1[8 + 2 * i + 1], sacc); }
                if (pvnow) AT_PV(m, false);
            }
            if (lag) { pend = true; vprev = vs; }
        } else if (KPIPE && t + 1 == tlo_w) AT_KLOAD(ksn);
        ks = ksn; vs = (vs + 1) & 3;
    }
    if (pend) { AT_VLOAD(vprev, 0, 8); AT_PV(NMAP - 1, true); }
    float inv[NMAP];
#pragma unroll
    for (int m = 0; m < NMAP; ++m) inv[m] = 1.f / swapsum(lsum[m]);
    f32x16 res[2];
    if (TYPE == 0) { float ss = 0.f;
#pragma unroll
        for (int dh = 0; dh < 2; ++dh)
#pragma unroll
            for (int r = 0; r < 16; ++r) { const float v = o[0][dh][r] * inv[0] - lam_full * (o[NMAP - 1][dh][r] * inv[NMAP - 1]); res[dh][r] = v; ss += v * v; }
        ss = swapsum(ss); const float rs = (1.f / sqrtf(ss * (1.f / 64) + LN_EPS)) * (1.f - lam_init);
#pragma unroll
        for (int dh = 0; dh < 2; ++dh)
#pragma unroll
            for (int r = 0; r < 16; ++r) res[dh][r] = res[dh][r] * rs * dng[32 * dh + crow(r, hi)];
    } else {
#pragma unroll
        for (int dh = 0; dh < 2; ++dh)
#pragma unroll
            for (int r = 0; r < 16; ++r) res[dh][r] = o[0][dh][r] * inv[0];
    }
    bf16* orow = Odst + (size_t)q * DM;
#pragma unroll
    for (int dh = 0; dh < 2; ++dh)
#pragma unroll
        for (int g = 0; g < 4; ++g) { u32x2 w; w.x = cvtpk(res[dh][4 * g], res[dh][4 * g + 1]); w.y = cvtpk(res[dh][4 * g + 2], res[dh][4 * g + 3]); *(u32x2*)(orow + 32 * dh + 8 * g + 4 * hi) = w; }
    asm volatile("s_waitcnt lgkmcnt(0)\n\ts_barrier" ::: "memory");
#undef AT_ISSUE_K
#undef AT_ISSUE_V
#undef AT_KLOAD
#undef AT_PV
#undef AT_VLOAD
#undef AT_VF
}

__device__ __forceinline__ void ph_attn(const Args& A, const Ctx& C0, int l) { const Ctx C = fresh(C0);
    const bf16* proj = WSP(bf16, WS_R1); const bf16* mq = WSP(bf16, WS_R2); const bf16* mk = WSP(bf16, WS_R2 + 24 * MiB); const bf16* mv = WSP(bf16, WS_R2 + 48 * MiB);
    const float* cumT = WSP(float, WS_MISC + MO_CUM); const float* btab = WSP(float, WS_MISC + MO_T5) + (size_t)l * 2 * 4 * 320; bf16* O = WSP(bf16, WS_R3);
    float lam_full; const float lam_init = 0.8f - 0.6f * expf(-0.3f * (float)l);
    { const float* lm = A.in[6] + l * 128; float a = 0.f, b = 0.f; for (int i = 0; i < 32; ++i) { a += lm[i] * lm[32 + i]; b += lm[64 + i] * lm[96 + i]; } lam_full = expf(a) - expf(b) + lam_init; }
    const float* dng = A.in[7] + l * 64;
    const int vcu = (C.G % 8 == 0) ? ((int)(blockIdx.x % 8) * (C.G / 8) + (int)(blockIdx.x / 8)) : (int)blockIdx.x;
    for (int up = vcu; up < 256; up += C.G) { const int bh = up >> 4, j = up & 15, b = bh >> 2, h = bh & 3; const size_t rb = (size_t)b * SEQ;
        const unsigned* qkm = WSP(unsigned, WS_CTL) + CW_QKMAX + l * 32; const float bqk = sqrtf(__uint_as_float(__hip_atomic_load(qkm + bh, __ATOMIC_RELAXED, __HIP_MEMORY_SCOPE_AGENT)) * __uint_as_float(__hip_atomic_load(qkm + 16 + bh, __ATOMIC_RELAXED, __HIP_MEMORY_SCOPE_AGENT))) * 1.001f;
        for (int k = 0; k < 2; ++k) { const int qb = k ? 31 - j : j;
            { AttnSrc S{proj + rb * NPROJ + PC_DQ + h * 64, proj + rb * NPROJ + PC_DK + h * 64, proj + rb * NPROJ + PC_DV + h * 64, NPROJ, NPROJ, NPROJ};
              attn_unit<0>(C, S, qb, btab + h * 320, nullptr, O + rb * DM + 0 * 256 + h * 64, lam_full, lam_init, dng, 0.f); }
            { AttnSrc S{mq + rb * 384 + h * 96, mk + rb * 384 + h * 96, mv + rb * 256 + h * 64, 384, 384, 256};
              attn_unit<2>(C, S, qb, nullptr, nullptr, O + rb * DM + 2 * 256 + h * 64, 0.f, 0.f, nullptr, 0.f); }
            { AttnSrc S{proj + rb * NPROJ + PC_FQ + h * 64, proj + rb * NPROJ + PC_FK + h * 64, proj + rb * NPROJ + PC_FV + h * 64, NPROJ, NPROJ, NPROJ};
              attn_unit<3>(C, S, qb, nullptr, cumT + (size_t)bh * SEQ, O + rb * DM + 3 * 256 + h * 64, 0.f, 0.f, nullptr, bqk); }
            { AttnSrc S{proj + rb * NPROJ + PC_BQ + h * 64, proj + rb * NPROJ + PC_BK + h * 64, proj + rb * NPROJ + PC_BV + h * 64, NPROJ, NPROJ, NPROJ};
              attn_unit<1>(C, S, qb, btab + (4 + h) * 320, nullptr, O + rb * DM + 1 * 256 + h * 64, 0.f, 0.f, nullptr, 0.f); }
        } }
}

struct MergeSched : pg8::PlainRows { const char* hb; const char* O; const char* Wg; const char* Wb; int G, c;
    __device__ __forceinline__ bool next(int i, pg8::Unit& u) const { int reg = c + G * (i >> 3); if (reg >= (NT / 256) * 4) return false;
        if ((G & 31) == 0) { const int x = c & 7, j = c >> 3, per = G >> 5; reg = ((i >> 3) * (G >> 2) + x * per + (j >> 2)) * 4 + (j & 3); }
        const int sq = i & 7, pm = reg >> 2, pc = reg & 3; u.pm = pm; u.pn = pc; u.aux = sq;
        if (sq < 4) { u.A = O + (size_t)pm * 256 * 2048 + sq * 512; u.B = Wb + (size_t)pc * 256 * 2048 + sq * 512; u.nt = 4; }
        else { u.A = hb + (size_t)pm * 256 * 2048; u.B = Wg + (size_t)((pc * 4 + (sq - 4)) * 256) * 2048; u.nt = 16; }
        return true; } };
struct EpiMerge { unsigned char* park; const float* bg; bf16* mg;
    __device__ __forceinline__ void operator()(const f32x4 (&acc)[2][2][4][2], const pg8::Unit& u, int tid, int wr, int wc, int fr, int fq) const {
        const __amdgpu_buffer_rsrc_t rs = __builtin_amdgcn_make_buffer_rsrc(park, 0, 512 * 1024, 0x00020000);
        if (u.aux < 4) { const int vo = ((wr * 64 + fr) * 256 + wc * 32 + 8 * fq) * 2, so = u.aux * 131072;
#pragma unroll
            for (int ai = 0; ai < 2; ++ai)
#pragma unroll
                for (int m = 0; m < 4; ++m)
#pragma unroll
                    for (int bj = 0; bj < 2; ++bj) __builtin_amdgcn_raw_buffer_store_b128(pack8(acc[ai][bj][m][0], acc[ai][bj][m][1]), rs, vo, so + (ai * 128 + m * 16) * 512 + bj * 256, 0);
        } else { const int cq = u.aux - 4; const int vo = ((wr * 64 + fr) * 256 + wc * 16 + fq * 4) * 2, so = cq * 128; const int c4 = u.pn * 256 + cq * 64 + wc * 16 + fq * 4;
            f32x4 bias[4];
#pragma unroll
            for (int n = 0; n < 4; ++n) bias[n] = *(const f32x4*)(bg + n * DM + c4);
#pragma unroll
            for (int ai = 0; ai < 2; ++ai) {
                u32x2 ub[4][4];
#pragma unroll
                for (int m = 0; m < 4; ++m)
#pragma unroll
                    for (int n = 0; n < 4; ++n) ub[m][n] = __builtin_amdgcn_raw_buffer_load_b64(rs, vo, so + n * 131072 + (ai * 128 + m * 16) * 512, 16);
#pragma unroll
                for (int m = 0; m < 4; ++m) { f32x4 t = {0.f, 0.f, 0.f, 0.f};
#pragma unroll
                    for (int n = 0; n < 4; ++n) { f32x4 g = acc[ai][n >> 1][m][n & 1] + bias[n]; const u32x2 uw = ub[m][n];
#pragma unroll
                        for (int i = 0; i < 4; ++i) g[i] = __builtin_amdgcn_rcpf(1.f + __builtin_amdgcn_exp2f(-LOG2E * g[i]));
                        t += g * (f32x4){bflo(uw.x), bfhi(uw.x), bflo(uw.y), bfhi(uw.y)}; }
                    u32x2 w; w.x = cvtpk(t[0], t[1]); w.y = cvtpk(t[2], t[3]);
                    *(u32x2*)(mg + (size_t)(u.pm * 256 + ai * 128 + wr * 64 + m * 16 + fr) * DM + c4) = w; } } } }
};
__device__ __forceinline__ void ph_merge(const Args& A, const Ctx& C0, int l) { const Ctx C = fresh(C0);
    MergeSched S; S.hb = (const char*)WSP(bf16, WS_HB); S.O = (const char*)WSP(bf16, WS_R3); S.Wg = (const char*)WSP(bf16, WS_WSM + l * WSM_STRIDE + WO_WG); S.Wb = (const char*)WSP(bf16, WS_WSM + l * WSM_STRIDE + WO_WB); S.G = C.G; S.c = blockIdx.x;
    unsigned char* park = C.ws + WS_R1 + (size_t)blockIdx.x * (512 * 1024);
    EpiMerge E{park, A.in[14] + (size_t)l * 4 * DM, WSP(bf16, WS_R2)};
    pg8::gemm_phase<false>(C.lds, C.tid, DM * 2, DM * 2, S, E);
}

__device__ __forceinline__ void ph_out(const Ctx& C0, int l) { const Ctx C = fresh(C0);
    GridSched S; S.A = (const char*)WSP(bf16, WS_R2); S.B = (const char*)WSP(bf16, WS_WSM + l * WSM_STRIDE + WO_WO); S.nM = NT / 256; S.nN = DM / 256; S.nt = DM / 64; S.G = C.G; S.c = blockIdx.x; S.lda = DM * 2; S.ldb = DM * 2;
    EpiStoreBf16 E{WSP(bf16, WS_R1), DM};
    pg8::gemm_phase<false>(C.lds, C.tid, DM * 2, DM * 2, S, E);
}

__device__ __forceinline__ void ph_conv_experts(const Args& A, const Ctx& C0, int l) { const Ctx C = fresh(C0);
    LAS float* scr = (LAS float*)(C.lds + C.wave * CONV_SCR);
    const float* W1b = A.in[23] + (size_t)l * NEXP * DM * DEXP; const float* W3b = A.in[24] + (size_t)l * NEXP * DM * DEXP; const float* W2b = A.in[25] + (size_t)l * NEXP * DEXP * DM;
    const long long d31 = (const char*)W3b - (const char*)W1b;
    for (int g = C.gw; g < NEXP * 384; g += C.ngw) { const int e = g / 384, r = g % 384; bf16* wb = WSP(bf16, WS_WEXP) + (size_t)e * 3 * DM * DEXP;
        if (r < 256) { const float* W1 = W1b + (size_t)e * DM * DEXP;
            auto f = [W1, d31](int k, int n) -> float { const long long o = (n & 128) ? d31 : 0ll; return ((const float*)((const char*)W1 + o))[(size_t)k * DEXP + (n >> 8) * 128 + (n & 127)]; };
            transpose_item(f, wb, DM, (r >> 4) * 64, (r & 15) * 64, scr, C.lane); }
        else { const int r2 = r - 256; const float* W2 = W2b + (size_t)e * DEXP * DM;
            auto f = [W2](int k, int n) -> float { return W2[(size_t)k * DM + n]; };
            transpose_item(f, wb + (size_t)2 * DM * DEXP, DEXP, (r2 >> 3) * 64, (r2 & 7) * 64, scr, C.lane); } }
}
__device__ __forceinline__ void ph_ln1_route(const Args& A, const Ctx& C0, int l, bool dry = false) { const Ctx C = fresh(C0);
    const bf16* y1 = WSP(bf16, WS_R1); bf16* hb = WSP(bf16, WS_HB); bf16* hbo = dry ? WSP(bf16, WS_R3) : hb;
    const float* g = A.in[17] + l * DM; const float* bb = A.in[18] + l * DM;
    const float* wrt = WSP(float, WS_MISC + MO_WRT) + (size_t)l * 36 * DM; const float* bgr = A.in[20] + l * 4; const float* be = A.in[22] + l * 32;
    float* gatev = WSP(float, WS_MISC + MO_GATE); int* list = WSP(int, WS_MISC + MO_LIST); unsigned* cnt = WSP(unsigned, WS_CTL) + CW_CNT + l * 32;
    LAS float* wel = (LAS float*)C.lds;
    LAS unsigned* lcnt = (LAS unsigned*)(C.lds + LDS_TAB); LAS unsigned* lbase = lcnt + 32;
    __syncthreads();
    for (int i = C.tid; i < 32 * DM / 4; i += NTHR) ((LAS f32x4*)wel)[i] = ((const f32x4*)(wrt + 4 * DM))[i];
    f32x4 wgr[4][4];
#pragma unroll
    for (int e = 0; e < 4; ++e)
#pragma unroll
        for (int j = 0; j < 4; ++j) wgr[e][j] = *(const f32x4*)(wrt + e * DM + 8 * C.lane + 512 * (j >> 1) + 4 * (j & 1));
    for (int blk = blockIdx.x; blk < NT / 128; blk += C.G) {
        if (C.tid < 32) lcnt[C.tid] = 0u;
        __syncthreads();
        int my_ea = 0, my_eb = 0; float my_ga = 0.f, my_gb = 0.f;
        f32x4 vn[4];
#pragma unroll
        for (int j = 0; j < 2; ++j) { const size_t o = (size_t)(blk * 128 + C.wave * 16) * DM + 8 * C.lane + 512 * j; f32x4 h0, h1, y0, y1v; ld8bf(hb + o, h0, h1); ld8bf(y1 + o, y0, y1v); vn[2 * j] = h0 * DN_ALPHA + y0; vn[2 * j + 1] = h1 * DN_ALPHA + y1v; }
        for (int r = 0; r < 16; ++r) { const int m = blk * 128 + C.wave * 16 + r; f32x4 v[4];
#pragma unroll
            for (int j = 0; j < 4; ++j) v[j] = vn[j];
            if (r + 1 < 16) {
#pragma unroll
                for (int j = 0; j < 2; ++j) { const size_t o = (size_t)(m + 1) * DM + 8 * C.lane + 512 * j; f32x4 h0, h1, y0, y1v; ld8bf(hb + o, h0, h1); ld8bf(y1 + o, y0, y1v); vn[2 * j] = h0 * DN_ALPHA + y0; vn[2 * j + 1] = h1 * DN_ALPHA + y1v; } }
            ln_row(v, g, bb, nullptr, hbo + (size_t)m * DM, C.lane);
            float gg[4];
#pragma unroll
            for (int e = 0; e < 4; ++e) { float p = 0.f;
#pragma unroll
                for (int j = 0; j < 4; ++j) p += (v[j].x * wgr[e][j].x + v[j].y * wgr[e][j].y) + (v[j].z * wgr[e][j].z + v[j].w * wgr[e][j].w);
                gg[e] = wave_sum_l(p, C.lane) + bgr[e]; }
            int gi = 0; float gm = gg[0];
#pragma unroll
            for (int i = 1; i < 4; ++i) if (gg[i] > gm) { gm = gg[i]; gi = i; }
            float gs = 0.f;
#pragma unroll
            for (int i = 0; i < 4; ++i) gs += expf(gg[i] - gm);
            const float g_val = 1.f / gs;
            gi = __builtin_amdgcn_readfirstlane(gi);
            float el[8];
#pragma unroll
            for (int e = 0; e < 8; ++e) { const LAS float* wr = wel + (gi * 8 + e) * DM + 8 * C.lane; float p = 0.f;
#pragma unroll
                for (int j = 0; j < 4; ++j) { const f32x4 w = *(const LAS f32x4*)(wr + 512 * (j >> 1) + 4 * (j & 1)); p += (v[j].x * w.x + v[j].y * w.y) + (v[j].z * w.z + v[j].w * w.w); }
                el[e] = wave_sum_l(p, C.lane) + be[gi * 8 + e]; }
            int i1 = 0; float m1 = el[0];
#pragma unroll
            for (int i = 1; i < 8; ++i) if (el[i] > m1) { m1 = el[i]; i1 = i; }
            int i2 = -1; float m2 = -1e30f;
#pragma unroll
            for (int i = 0; i < 8; ++i) if (i != i1 && el[i] > m2) { m2 = el[i]; i2 = i; }
            const float p2 = expf(m2 - m1); const float ga = g_val / (1.f + p2), gb = g_val * p2 / (1.f + p2);
            if (C.lane == r) { my_ea = gi * 8 + i1; my_eb = gi * 8 + i2; my_ga = ga; my_gb = gb; } }
        unsigned ia = 0u, ib = 0u;
        if (dry) continue;
        if (C.lane < 16) { ia = __hip_atomic_fetch_add(lcnt + my_ea, 1u, __ATOMIC_RELAXED, __HIP_MEMORY_SCOPE_WORKGROUP); ib = __hip_atomic_fetch_add(lcnt + my_eb, 1u, __ATOMIC_RELAXED, __HIP_MEMORY_SCOPE_WORKGROUP); }
        __syncthreads();
        if (C.tid < 32) lbase[C.tid] = atomicAdd(cnt + C.tid, lcnt[C.tid]);
        __syncthreads();
        if (C.lane < 16) { const int m = blk * 128 + C.wave * 16 + C.lane;
            gatev[2 * m] = my_ga; gatev[2 * m + 1] = my_gb;
            list[(size_t)my_ea * NSLOT + lbase[my_ea] + ia] = 2 * m; list[(size_t)my_eb * NSLOT + lbase[my_eb] + ib] = 2 * m + 1; }
        __syncthreads();
    }
}

__device__ __forceinline__ void moe_tables(const Ctx& C, int l, LAS int* tb, LAS int* cn) {
    const unsigned* cnt = WSP(unsigned, WS_CTL) + CW_CNT + l * 32;
    __syncthreads();
    if (C.tid == 0) { int t = 0; for (int e = 0; e < NEXP; ++e) { const int c = (int)__hip_atomic_load(cnt + e, __ATOMIC_RELAXED, __HIP_MEMORY_SCOPE_AGENT); cn[e] = c; tb[e] = t; t += (c + 255) / 256; } tb[NEXP] = t; }
    __syncthreads();
}
struct MoeSched { const char* hb; const char* hbuf; const char* wexp; const int* list; LAS int* tb; LAS int* cn; int G, c, up;
    __device__ __forceinline__ bool next(int i, pg8::Unit& u) const { const int cx = (G & 7) == 0 ? (c & 7) * (G >> 3) + (c >> 3) : c;
        const int L = i * G + cx; if (L >= tb[NEXP] * 4) return false;
        const int tg = L >> 2, pn = L & 3; int e = 0; while (tb[e + 1] <= tg) ++e;
        u.pm = tg; u.pn = pn; u.aux = e | ((tg - tb[e]) << 8);
        if (up) { u.A = hb; u.B = wexp + (size_t)e * 3 * DM * DEXP * 2 + (size_t)pn * 256 * 2048; u.nt = 16; }
        else { u.A = hbuf + (size_t)tg * 256 * (DEXP * 2); u.B = wexp + (size_t)e * 3 * DM * DEXP * 2 + (size_t)2 * DM * DEXP * 2 + (size_t)pn * 256 * (DEXP * 2); u.nt = 8; }
        return true; }
    __device__ __forceinline__ void a_rows(const pg8::Unit& u, const int (&RA)[2], const int (&CA2)[2], int lda, unsigned (&va)[2][2]) const {
        const int e = u.aux & 255, ti = u.aux >> 8, c_e = cn[e];
#pragma unroll
        for (int h = 0; h < 2; ++h)
#pragma unroll
            for (int i = 0; i < 2; ++i) { const int r = h * 128 + RA[i];
                if (up) { const int rr = ti * 256 + r; const int tok = rr < c_e ? (list[(size_t)e * NSLOT + rr] >> 1) : 0; va[h][i] = (unsigned)tok * 2048u + (unsigned)CA2[i]; }
                else va[h][i] = (unsigned)(r * lda + CA2[i]); } }
};
struct EpiExpUp { bf16* hbuf;
    __device__ __forceinline__ void operator()(const f32x4 (&acc)[2][2][4][2], const pg8::Unit& u, int tid, int wr, int wc, int fr, int fq) const {
        const int row0 = u.pm * 256 + wr * 64 + fr, col0 = u.pn * 128 + wc * 32 + 8 * fq;
#pragma unroll
        for (int ai = 0; ai < 2; ++ai)
#pragma unroll
            for (int m = 0; m < 4; ++m) { f32x4 h0, h1;
#pragma unroll
                for (int i = 0; i < 4; ++i) { const float a0 = acc[ai][0][m][0][i], a1 = acc[ai][0][m][1][i];
                    h0[i] = a0 * __builtin_amdgcn_rcpf(1.f + __builtin_amdgcn_exp2f(-LOG2E * a0)) * acc[ai][1][m][0][i]; h1[i] = a1 * __builtin_amdgcn_rcpf(1.f + __builtin_amdgcn_exp2f(-LOG2E * a1)) * acc[ai][1][m][1][i]; }
                *(u32x4*)(hbuf + (size_t)(row0 + ai * 128 + m * 16) * DEXP + col0) = pack8(h0, h1); } }
};
struct EpiExpDown { bf16* ys; const int* list; const float* gatev; int* inv; LAS int* cn;
    __device__ __forceinline__ void operator()(const f32x4 (&acc)[2][2][4][2], const pg8::Unit& u, int tid, int wr, int wc, int fr, int fq) const {
        const int e = u.aux & 255, ti = u.aux >> 8, c_e = cn[e]; const int col0 = u.pn * 256 + wc * 32 + 8 * fq;
#pragma unroll
        for (int ai = 0; ai < 2; ++ai)
#pragma unroll
            for (int m = 0; m < 4; ++m) { const int rl = ai * 128 + wr * 64 + m * 16 + fr, rr = ti * 256 + rl;
                if (rr < c_e) { const int slot = list[(size_t)e * NSLOT + rr]; const float g = gatev[slot]; const size_t dest = (size_t)u.pm * 256 + rl;
#pragma unroll
                    for (int bj = 0; bj < 2; ++bj) *(u32x4*)(ys + dest * DM + col0 + bj * 128) = pack8(acc[ai][bj][m][0] * g, acc[ai][bj][m][1] * g);
                    if (u.pn == 0 && wc == 0 && fq == 0) inv[slot] = (int)dest; } } }
};
__device__ __forceinline__ void ph_exp_up(const Ctx& C0, int l) { const Ctx C = fresh(C0);
    LAS int* tb = (LAS int*)(C.lds + LDS_TAB); LAS int* cn = tb + 64;
    moe_tables(C, l, tb, cn);
    MoeSched S; S.hb = (const char*)WSP(bf16, WS_HB); S.hbuf = (const char*)WSP(bf16, WS_R3); S.wexp = (const char*)WSP(bf16, WS_WEXP); S.list = WSP(int, WS_MISC + MO_LIST); S.tb = tb; S.cn = cn; S.G = C.G; S.c = blockIdx.x; S.up = 1;
    EpiExpUp E{WSP(bf16, WS_R3)};
    pg8::gemm_phase<true>(C.lds, C.tid, DM * 2, DM * 2, S, E);
}
__device__ __forceinline__ void ph_exp_down(const Ctx& C0, int l) { const Ctx C = fresh(C0);
    LAS int* tb = (LAS int*)(C.lds + LDS_TAB); LAS int* cn = tb + 64;
    moe_tables(C, l, tb, cn);
    MoeSched S; S.hb = (const char*)WSP(bf16, WS_HB); S.hbuf = (const char*)WSP(bf16, WS_R3); S.wexp = (const char*)WSP(bf16, WS_WEXP); S.list = WSP(int, WS_MISC + MO_LIST); S.tb = tb; S.cn = cn; S.G = C.G; S.c = blockIdx.x; S.up = 0;
    EpiExpDown E{WSP(bf16, WS_R1), WSP(int, WS_MISC + MO_LIST), WSP(float, WS_MISC + MO_GATE), WSP(int, WS_MISC + MO_INV), cn};
    pg8::gemm_phase<false>(C.lds, C.tid, DEXP * 2, DEXP * 2, S, E);
}
__device__ __forceinline__ void ph_combine(const Args& A, const Ctx& C0, int l, bool dry = false) { const Ctx C = fresh(C0);
    const int* inv = WSP(int, WS_MISC + MO_INV); const bf16* ys = WSP(bf16, WS_R1); bf16* hb = WSP(bf16, WS_HB); bf16* hbo = dry ? WSP(bf16, WS_R3) : hb;
    const float* g = A.in[26] + l * DM; const float* bb = A.in[27] + l * DM;
    for (int m = 2 * C.gw; m < NT; m += 2 * C.ngw) {
        const int4 iv = *(const int4*)(inv + 2 * m); f32x4 v[2][4];
#pragma unroll
        for (int r = 0; r < 2; ++r) { const size_t d0 = (size_t)(r ? iv.z : iv.x), d1 = (size_t)(r ? iv.w : iv.y);
#pragma unroll
            for (int j = 0; j < 2; ++j) { const int c = 8 * C.lane + 512 * j; f32x4 h0, h1, a0, a1, b0, b1;
                ld8bf(hb + (size_t)(m + r) * DM + c, h0, h1); ld8bf(ys + d0 * DM + c, a0, a1); ld8bf(ys + d1 * DM + c, b0, b1);
                v[r][2 * j] = h0 * DN_ALPHA + a0 + b0; v[r][2 * j + 1] = h1 * DN_ALPHA + a1 + b1; } }
#pragma unroll
        for (int r = 0; r < 2; ++r) ln_row(v[r], g, bb, (l == NL - 1 && !dry) ? C.hf + (size_t)(m + r) * DM : nullptr, hbo + (size_t)(m + r) * DM, C.lane); }
}

__global__ void __launch_bounds__(NTHR, 2) fwd(Args args) {
    extern __shared__ __attribute__((aligned(16))) unsigned char lds_raw[];
    Ctx C;
    C.hf = args.out; C.ws = args.ws; C.lds = (LAS unsigned char*)lds_raw;
    C.tid = threadIdx.x; C.lane = C.tid & 63; C.wave = __builtin_amdgcn_readfirstlane(C.tid >> 6); C.G = gridDim.x;
    C.gw = blockIdx.x * NWAVES + C.wave; C.ngw = C.G * NWAVES;
    for (int u = C.tid; u < (LDS_BYTES - LDS_MISC) / 4; u += NTHR) ((LAS unsigned*)(C.lds + LDS_MISC))[u] = 0u;
    __syncthreads();
    XcdBarrier bar = xcd_barrier_post(WSP(unsigned, WS_CTL) + CW_BAR, (volatile LAS unsigned*)(C.lds + LDS_MISC), (unsigned)C.wave);
#define GRID_BAR() do { XcdBarrier b_ = bar; asm volatile("" : "+s"(b_.bar), "+s"(b_.x), "+s"(b_.wv)); xcd_barrier(b_); } while (0)
#define RUNPH(k, call) do { call; GRID_BAR(); if (PROBE_DUP == (k)) { call; GRID_BAR(); } } while (0)
    ph_prologue(args, C); GRID_BAR(); if (PROBE_DUP == 0) { ph_prologue(args, C); GRID_BAR(); }
    for (int l = 0; l < NL; ++l) {
        RUNPH(1, ph_proj(args, C, l));
        RUNPH(3, ph_mla_up(args, C, l));
        RUNPH(4, ph_attn(args, C, l));
        RUNPH(5, ph_merge(args, C, l));
        RUNPH(6, ph_out(C, l));
        ph_conv_experts(args, C, l); if (PROBE_DUP == 7) ph_conv_experts(args, C, l);
        if (PROBE_DUP == 10) { ph_ln1_route(args, C, l, true); GRID_BAR(); }
        ph_ln1_route(args, C, l); GRID_BAR();
        RUNPH(8, ph_exp_up(C, l));
        RUNPH(9, ph_exp_down(C, l));
        if (PROBE_DUP == 11) { ph_combine(args, C, l, true); GRID_BAR(); }
        ph_combine(args, C, l); if (l + 1 < NL) GRID_BAR();
    }
}

extern "C" void kernel_launch(void* const* d_in, const int* in_sizes, int n_in, void* d_out, int out_size, void* d_ws, size_t ws_size, hipStream_t stream) {
    static int grid = 0;
    if (grid == 0) {
        if (n_in != 28 || out_size != NT * DM || ws_size < WS_END) { fprintf(stderr, "kernel_launch: unexpected shapes (n_in %d out %d ws %zu)\n", n_in, out_size, ws_size); grid = -1; return; }
        int dev = 0, cus = 0, per_cu = 0;
        if (hipGetDevice(&dev) != hipSuccess || hipDeviceGetAttribute(&cus, hipDeviceAttributeMultiprocessorCount, dev) != hipSuccess) { grid = -1; return; }
        if (hipFuncSetAttribute((const void*)fwd, hipFuncAttributeMaxDynamicSharedMemorySize, LDS_BYTES) != hipSuccess) { grid = -1; return; }
        if (hipOccupancyMaxActiveBlocksPerMultiprocessor(&per_cu, (const void*)fwd, NTHR, LDS_BYTES) != hipSuccess || per_cu < 1) { fprintf(stderr, "kernel_launch: occupancy query says %d blocks per CU\n", per_cu); (void)hipGetLastError(); grid = -1; return; }
        grid = cus;
    }
    if (grid < 0) return;
    (void)hipMemsetAsync((char*)d_ws + WS_CTL, 0, CTL_BYTES, stream);
    Args a{};
    for (int i = 0; i < 28; ++i) a.in[i] = (const float*)d_in[i];
    a.out = (float*)d_out; a.ws = (unsigned char*)d_ws; a.ph_lo = 0; a.ph_hi = 0;
    hipLaunchKernelGGL(fwd, dim3(grid), dim3(NTHR), LDS_BYTES, stream, a);
}
```

```cpp
#include <hip/hip_runtime.h>
#include <cstdio>
#include <cstdint>
#ifndef PROBE_DUP
#define PROBE_DUP -1
#endif

#define GAS __attribute__((address_space(1)))
#define LAS __attribute__((address_space(3)))
typedef unsigned short bf16;
typedef short bf16x8 __attribute__((ext_vector_type(8)));
typedef float f32x4 __attribute__((ext_vector_type(4)));
typedef float f32x16 __attribute__((ext_vector_type(16)));
typedef unsigned u32x4 __attribute__((ext_vector_type(4)));
typedef unsigned u32x2 __attribute__((ext_vector_type(2)));

constexpr int NB = 4, SEQ = 8192, DM = 1024, NT = NB * SEQ, NL = 2;
constexpr int DIN = 2724, NPROJ = 2816;
constexpr int PC_DQ = 0, PC_DK = 256, PC_DV = 512, PC_BQ = 768, PC_BK = 1024, PC_BV = 1280, PC_CQ = 1536, PC_FQ = 1792, PC_FK = 2048, PC_FV = 2304,
              PC_CKV = 2560, PC_KR = 2688, PC_FF = 2720;
constexpr float LOG2E = 1.4426950408889634f;
constexpr float SC32 = 0.17677669529663687f * LOG2E, SC64 = 0.125f * LOG2E, SC96 = 0.10206207261596575f * LOG2E;
constexpr float LN_EPS = 1e-5f;
constexpr float DN_ALPHA = 1.4142135623730951f;
constexpr int NEXP = 32, DEXP = 512, NSLOT = NT * 2, MAXROWS = NSLOT + NEXP * 256;

constexpr size_t MiB = 1u << 20;
constexpr size_t WS_CTL = 0, CTL_BYTES = 1 * MiB;
constexpr size_t WS_WSM = 1 * MiB, WSM_STRIDE = 20 * MiB;
constexpr size_t WO_WIN = 0, WO_WG = 6 * MiB, WO_WB = 14 * MiB, WO_WO = 16 * MiB, WO_WUQ = 18 * MiB, WO_WUKV = 18 * MiB + 512 * 1024;
constexpr size_t WS_MISC = 41 * MiB;
constexpr size_t MO_ROPE = 0, MO_T5 = 1 * MiB, MO_RSTD = 1 * MiB + 64 * 1024, MO_WRT = 1 * MiB + 384 * 1024  , MO_SUM64 = 1 * MiB + 768 * 1024  , MO_CUM = 2 * MiB, MO_EID = 3 * MiB, MO_GATE = 3 * MiB + 512 * 1024, MO_INV = 4 * MiB, MO_LIST = 5 * MiB;
constexpr size_t WS_WEXP = 56 * MiB;
constexpr size_t WS_HB = 152 * MiB;
constexpr size_t WS_R1 = 216 * MiB;
constexpr size_t WS_R2 = 392 * MiB;
constexpr size_t WS_R3 = 456 * MiB;
constexpr size_t WS_END = 528 * MiB;
constexpr int CW_CNT = 1024, CW_QKMAX = 2048  , CW_BAR = 4096;

constexpr int NWAVES = 8, NTHR = 512;
constexpr int LDS_BYTES = 147456, LDS_TAB = 131072, LDS_MISC = 131072 + 4096;

struct Args { const float* in[28]; float* out; unsigned char* ws; int ph_lo, ph_hi; };

__device__ __forceinline__ unsigned f2bf(float f) { unsigned u = __builtin_bit_cast(unsigned, f); return (u + 0x7fffu + ((u >> 16) & 1u)) >> 16; }
__device__ __forceinline__ unsigned pk2(float lo, float hi) { return f2bf(lo) | (f2bf(hi) << 16); }
__device__ __forceinline__ float bflo(unsigned w) { return __builtin_bit_cast(float, w << 16); }
__device__ __forceinline__ float bfhi(unsigned w) { return __builtin_bit_cast(float, w & 0xffff0000u); }
__device__ __forceinline__ float bf2f(bf16 b) { return __builtin_bit_cast(float, (unsigned)b << 16); }
__device__ __forceinline__ int crow(int r, int hi) { return (r & 3) + 8 * (r >> 2) + 4 * hi; }
__device__ __forceinline__ int lane_id_asm() { int l; asm volatile("v_mbcnt_lo_u32_b32 %0, -1, 0\n\tv_mbcnt_hi_u32_b32 %0, -1, %0" : "=v"(l)); return l; }
__device__ __forceinline__ float shfl_xor_l(float v, int o, int lane) { return __builtin_bit_cast(float, __builtin_amdgcn_ds_bpermute((lane ^ o) << 2, __builtin_bit_cast(int, v))); }
__device__ __forceinline__ float shfl_up_l(float v, int o, int lane) { return __builtin_bit_cast(float, __builtin_amdgcn_ds_bpermute((lane - o) << 2, __builtin_bit_cast(int, v))); }
__device__ __forceinline__ float wave_sum_l(float v, int) {
    v += __builtin_bit_cast(float, __builtin_amdgcn_update_dpp(0, __builtin_bit_cast(int, v), 0x111, 0xf, 0xf, true));
    v += __builtin_bit_cast(float, __builtin_amdgcn_update_dpp(0, __builtin_bit_cast(int, v), 0x112, 0xf, 0xf, true));
    v += __builtin_bit_cast(float, __builtin_amdgcn_update_dpp(0, __builtin_bit_cast(int, v), 0x114, 0xf, 0xf, true));
    v += __builtin_bit_cast(float, __builtin_amdgcn_update_dpp(0, __builtin_bit_cast(int, v), 0x118, 0xf, 0xf, true));
    v += __builtin_bit_cast(float, __builtin_amdgcn_update_dpp(0, __builtin_bit_cast(int, v), 0x142, 0xa, 0xf, false));
    v += __builtin_bit_cast(float, __builtin_amdgcn_update_dpp(0, __builtin_bit_cast(int, v), 0x143, 0xc, 0xf, false));
    return __builtin_bit_cast(float, __builtin_amdgcn_readlane(__builtin_bit_cast(int, v), 63));
}
__device__ __forceinline__ unsigned cvtpk(float lo, float hi) { unsigned r; asm("v_cvt_pk_bf16_f32 %0, %1, %2" : "=v"(r) : "v"(lo), "v"(hi)); return r; }
__device__ __forceinline__ unsigned cvtpk_dep(float lo, float hi, float dep) { unsigned r; asm("v_cvt_pk_bf16_f32 %0, %1, %2" : "=v"(r) : "v"(lo), "v"(hi), "v"(dep)); return r; }
__device__ __forceinline__ void glds16(const void* gbase, unsigned voff, unsigned lds_dst) { unsigned keep;
    asm volatile("s_mov_b32 %0, m0\n\ts_mov_b32 m0, %3\n\ts_nop 0\n\tglobal_load_lds_dwordx4 %1, %2\n\ts_mov_b32 m0, %0" : "=&s"(keep) : "v"(voff), "s"(gbase), "s"(lds_dst) : "memory"); }
#define MFMA32(a, b, c) __builtin_amdgcn_mfma_f32_32x32x16_bf16(a, b, c, 0, 0, 0)

template <int N> __device__ __forceinline__ void wave_gemm(const bf16* arow, const bf16* const (&brow)[N], int K, int hi, f32x16 (&acc)[N]) {
#pragma unroll 4
    for (int k = 0; k < K; k += 16) {
        const bf16x8 a = *(const bf16x8*)(arow + k + 8 * hi);
#pragma unroll
        for (int n = 0; n < N; ++n) { const bf16x8 b = *(const bf16x8*)(brow[n] + k + 8 * hi); acc[n] = MFMA32(a, b, acc[n]); }
    }
}

constexpr int CONV_SCR = 16896;
template <class F> __device__ __forceinline__ void transpose_item(const F& f, bf16* WT, int ldk, int n0, int k0, LAS float* scr, int lane) {
#pragma unroll
    for (int kk = 0; kk < 64; ++kk) scr[kk * 65 + lane] = f(k0 + kk, n0 + lane);
    asm volatile("s_waitcnt lgkmcnt(0)" ::: "memory");
    const int c = lane & 7;
#pragma unroll
    for (int j = 0; j < 8; ++j) { const int n = (lane >> 3) + 8 * j; const LAS float* s = scr + (8 * c) * 65 + n;
        u32x4 o; o.x = pk2(s[0 * 65], s[1 * 65]); o.y = pk2(s[2 * 65], s[3 * 65]); o.z = pk2(s[4 * 65], s[5 * 65]); o.w = pk2(s[6 * 65], s[7 * 65]);
        *(u32x4*)(WT + (size_t)(n0 + n) * ldk + k0 + 8 * c) = o; }
    asm volatile("s_waitcnt lgkmcnt(0)" ::: "memory");
}
template <class F> __device__ __forceinline__ void conv_matrix(const F& f, bf16* WT, int nrows, int kcols, LAS float* scr, int lane, int gw, int ngw, int& base) {
    const int nkb = kcols / 64, items = (nrows / 64) * nkb; int first = (gw - base) % ngw; if (first < 0) first += ngw;
    for (int it = first; it < items; it += ngw) transpose_item(f, WT, kcols, (it / nkb) * 64, (it % nkb) * 64, scr, lane);
    base += items;
}

__device__ __forceinline__ void sincos_acc(float ang, float& s, float& c) {
    const double x = (double)ang; const double kq = __builtin_rint(x * 0.63661977236758134308);
    double r = __builtin_fma(-kq, 1.57079632679489655800e+00, x); r = __builtin_fma(-kq, 6.12323399573676603587e-17, r);
    const double r2 = r * r;
    double sp = r * (1.0 + r2 * (-1.0 / 6 + r2 * (1.0 / 120 + r2 * (-1.0 / 5040 + r2 * (1.0 / 362880 + r2 * (-1.0 / 39916800 + r2 * (1.0 / 6227020800.0)))))));
    double cp = 1.0 + r2 * (-0.5 + r2 * (1.0 / 24 + r2 * (-1.0 / 720 + r2 * (1.0 / 40320 + r2 * (-1.0 / 3628800 + r2 * (1.0 / 479001600.0))))));
    const int q = ((int)kq) & 3;
    double ss = (q & 1) ? cp : sp, cc = (q & 1) ? sp : cp;
    if (q == 1) cc = -cc; else if (q == 2) { ss = -ss; cc = -cc; } else if (q == 3) ss = -ss;
    s = (float)ss; c = (float)cc;
}


namespace pg8 {
constexpr int BM = 256, BK = 64, HALF = 128, HTB = HALF * BK * 2, STAGE_BYTES = 8 * HTB;
__device__ __forceinline__ int lds_byte(int r, int c) { const int st = (r >> 4) * 2 + (c >> 5), rr = r & 15, cc = c & 31, ob = rr * 64 + cc * 2; return st * 1024 + (ob ^ (((ob >> 9) & 1) << 5)); }
__device__ __forceinline__ void stage_rc(int b, int& R, int& Cc) { const int st = b / 1024, sb = b % 1024, swz = sb ^ (((sb >> 9) & 1) << 5); R = (st >> 1) * 16 + swz / 64; Cc = (st & 1) * 32 + (swz % 64) / 2; }
__device__ __forceinline__ int perm32(int rho) { const int n = rho >> 4, i = rho & 15; return 8 * (i >> 2) + 4 * n + (i & 3); }
struct Unit { int pm, pn, nt, aux; const char* A; const char* B; };
template <bool GATHER, class Epi, class Sched> __device__ __forceinline__ void gemm_phase(LAS unsigned char* lds, const int tid_in, const int lda, const int ldb, const Sched& S, const Epi& E) {
    int tid_ = tid_in; asm volatile("" : "+v"(tid_));
    const int tid = tid_, wid = __builtin_amdgcn_readfirstlane(tid >> 6), lane = tid & 63, wr = wid >> 2, wc = wid & 3, fr = lane & 15, fq = lane >> 4;
    int RA[2], CA2[2]; unsigned voffB[2];
#pragma unroll
    for (int i = 0; i < 2; ++i) { int R, Cc; stage_rc(tid * 16 + i * 8192, R, Cc); RA[i] = R; CA2[i] = Cc * 2; const int Rb = (R & ~31) + perm32(R & 31); voffB[i] = (unsigned)(Rb * ldb + Cc * 2); }
    const size_t kstep = (size_t)(BK * 2); const size_t hstepB = (size_t)HALF * ldb;
    const unsigned ldsb = (unsigned)(uintptr_t)lds + (unsigned)wid * 1024u;
    const int aoff = lds_byte(wr * 64 + fr, fq * 8), boff = lds_byte(wc * 32 + fr, fq * 8);
#define PG8_SA(b, h) (((b) * 2 + (h)) * HTB)
#define PG8_SB(b, h) ((4 + (b) * 2 + (h)) * HTB)
#define PG8_STAGE(bufoff, gbase, voff) do { _Pragma("unroll") for (int _i = 0; _i < 2; ++_i) \
        glds16((const char*)(gbase), (voff)[_i], (unsigned)__builtin_amdgcn_readfirstlane(ldsb + (unsigned)((bufoff) + _i * 8192))); } while (0)
#define PG8_LDA(dst, b, h) do { _Pragma("unroll") for (int m = 0; m < 4; ++m) _Pragma("unroll") for (int k = 0; k < 2; ++k) dst[m][k] = *(const LAS bf16x8*)(lds + PG8_SA(b, h) + aoff + m * 2048 + k * 1024); } while (0)
#define PG8_LDB(dst, b, h) do { _Pragma("unroll") for (int n = 0; n < 2; ++n) _Pragma("unroll") for (int k = 0; k < 2; ++k) dst[n][k] = *(const LAS bf16x8*)(lds + PG8_SB(b, h) + boff + n * 2048 + k * 1024); } while (0)
#define PG8_MMA(ai, bj, At, Bt) do { __builtin_amdgcn_s_setprio(1); _Pragma("unroll") for (int m = 0; m < 4; ++m) _Pragma("unroll") for (int n = 0; n < 2; ++n) _Pragma("unroll") for (int k = 0; k < 2; ++k) \
        acc[ai][bj][m][n] = __builtin_amdgcn_mfma_f32_16x16x32_bf16(Bt[n][k], At[m][k], acc[ai][bj][m][n], 0, 0, 0); __builtin_amdgcn_s_setprio(0); } while (0)
#define PG8_WAIT_V(n) asm volatile("s_waitcnt vmcnt(" #n ")" ::: "memory")
#define PG8_WAIT_L(n) asm volatile("s_waitcnt lgkmcnt(" #n ")" ::: "memory")
#define PG8_BAR __builtin_amdgcn_s_barrier()
#define PG8_SCHED __builtin_amdgcn_sched_barrier(0)
    Unit cur, nxt; int ui = 0;
    if (!S.next(0, cur)) return;
    f32x4 acc[2][2][4][2];
#pragma unroll
    for (int a = 0; a < 2; ++a)
#pragma unroll
        for (int b = 0; b < 2; ++b)
#pragma unroll
            for (int m = 0; m < 4; ++m)
#pragma unroll
                for (int n = 0; n < 2; ++n) acc[a][b][m][n] = (f32x4){0.f, 0.f, 0.f, 0.f};
    bf16x8 At[4][2], B0[2][2], B1[2][2];
    unsigned va[2][2], nva[2][2];
    S.a_rows(cur, RA, CA2, lda, va);
    const char* cA = cur.A; const char* cB = cur.B;
    PG8_STAGE(PG8_SB(0, 0), cB, voffB); PG8_STAGE(PG8_SB(0, 1), cB + hstepB, voffB); PG8_STAGE(PG8_SA(0, 0), cA, va[0]); PG8_STAGE(PG8_SA(0, 1), cA, va[1]);
    if (wr == 1) PG8_BAR;
    PG8_WAIT_V(2); PG8_BAR;
    PG8_STAGE(PG8_SB(1, 0), cB + kstep, voffB); PG8_STAGE(PG8_SA(1, 0), cA + kstep, va[0]); PG8_STAGE(PG8_SB(1, 1), cB + hstepB + kstep, voffB);
    PG8_WAIT_V(6); PG8_BAR;
    for (;;) {
        const bool has_next = S.next(ui + 1, nxt);
        const char* nA = has_next ? nxt.A : cA; const char* nB = has_next ? nxt.B : cB;
        if (GATHER && has_next) S.a_rows(nxt, RA, CA2, lda, nva); else { nva[0][0] = va[0][0]; nva[0][1] = va[0][1]; nva[1][0] = va[1][0]; nva[1][1] = va[1][1]; }
        int nt_ = cur.nt; asm volatile("" : "+s"(nt_)); const int nt = nt_;
        for (int t = 0; t < nt; t += 2) {
            const bool last = (t == nt - 2);
            const char* a1 = cA + (size_t)(t + 1) * kstep;
            const char* a2 = last ? nA : cA + (size_t)(t + 2) * kstep; const char* b2 = last ? nB : cB + (size_t)(t + 2) * kstep;
            const char* a3 = a2 + kstep; const char* b3 = b2 + kstep;
            unsigned xv[2][2];
#pragma unroll
            for (int h = 0; h < 2; ++h)
#pragma unroll
                for (int i = 0; i < 2; ++i) xv[h][i] = (GATHER && last) ? nva[h][i] : va[h][i];
            PG8_LDB(B0, 0, 0); PG8_LDB(B1, 0, 1); PG8_SCHED; PG8_LDA(At, 0, 0); PG8_STAGE(PG8_SA(1, 1), a1, va[1]);
            PG8_WAIT_V(8); PG8_WAIT_L(0); PG8_BAR; PG8_MMA(0, 0, At, B0); PG8_MMA(0, 1, At, B1); PG8_BAR; PG8_SCHED;
            PG8_LDA(At, 0, 1); PG8_STAGE(PG8_SB(0, 0), b2, voffB); PG8_STAGE(PG8_SB(0, 1), b2 + hstepB, voffB); PG8_STAGE(PG8_SA(0, 0), a2, xv[0]);
            PG8_WAIT_V(8); PG8_WAIT_L(0); PG8_BAR; PG8_MMA(1, 0, At, B0); PG8_MMA(1, 1, At, B1); PG8_BAR; PG8_SCHED;
            PG8_LDB(B0, 1, 0); PG8_LDB(B1, 1, 1); PG8_SCHED; PG8_LDA(At, 1, 0); PG8_STAGE(PG8_SA(0, 1), a2, xv[1]);
            PG8_WAIT_V(8); PG8_WAIT_L(0); PG8_BAR; PG8_MMA(0, 0, At, B0); PG8_MMA(0, 1, At, B1); PG8_BAR; PG8_SCHED;
            PG8_LDA(At, 1, 1); PG8_STAGE(PG8_SB(1, 0), b3, voffB); PG8_STAGE(PG8_SB(1, 1), b3 + hstepB, voffB); PG8_STAGE(PG8_SA(1, 0), a3, xv[0]);
            PG8_WAIT_V(8); PG8_WAIT_L(0); PG8_BAR; PG8_MMA(1, 0, At, B0); PG8_MMA(1, 1, At, B1); PG8_BAR; PG8_SCHED;
        }
        if (wr == 0) PG8_BAR;
        { int tid_e = tid, fr_e = fr, fq_e = fq; asm volatile("" : "+v"(tid_e), "+v"(fr_e), "+v"(fq_e));
          E(acc, cur, tid_e, wr, wc, fr_e, fq_e); }
        if (!has_next) break;
#pragma unroll
        for (int a = 0; a < 2; ++a)
#pragma unroll
            for (int b = 0; b < 2; ++b)
#pragma unroll
                for (int m = 0; m < 4; ++m)
#pragma unroll
                    for (int n = 0; n < 2; ++n) acc[a][b][m][n] = (f32x4){0.f, 0.f, 0.f, 0.f};
        cur = nxt; cA = nA; cB = nB; ++ui;
#pragma unroll
        for (int h = 0; h < 2; ++h)
#pragma unroll
            for (int i = 0; i < 2; ++i) va[h][i] = nva[h][i];
        if (wr == 1) PG8_BAR;
    }
    PG8_WAIT_V(0);
    PG8_BAR;
#undef PG8_SA
#undef PG8_SB
#undef PG8_STAGE
#undef PG8_LDA
#undef PG8_LDB
#undef PG8_MMA
#undef PG8_WAIT_V
#undef PG8_WAIT_L
#undef PG8_BAR
#undef PG8_SCHED
}
struct PlainRows { __device__ __forceinline__ void a_rows(const Unit&, const int (&RA)[2], const int (&CA2)[2], int lda, unsigned (&va)[2][2]) const {
#pragma unroll
    for (int h = 0; h < 2; ++h)
#pragma unroll
        for (int i = 0; i < 2; ++i) va[h][i] = (unsigned)((h * HALF + RA[i]) * lda + CA2[i]); } };
}

struct GridSched : pg8::PlainRows {
    const char* A; const char* B; int nM, nN, nt, G, c, lda, ldb;
    __device__ __forceinline__ bool next(int i, pg8::Unit& u) const {
        const int nwg = nM * nN; const long L = (long)i * G + c; if (L >= nwg) return false;
        int wgid = (int)L; { const int q = nwg / 8, r = nwg % 8, xcd = wgid % 8, off = wgid / 8; wgid = (xcd < r ? xcd * (q + 1) : r * (q + 1) + (xcd - r) * q) + off; }
        const int nig = 8 * nN, gid = wgid / nig, fm = gid * 8, gsz = (nM - fm) < 8 ? (nM - fm) : 8;
        u.pm = fm + ((wgid % nig) % gsz); u.pn = (wgid % nig) / gsz; u.nt = nt; u.aux = 0;
        u.A = A + (size_t)u.pm * 256 * lda; u.B = B + (size_t)u.pn * 256 * ldb; return true; }
};
__device__ __forceinline__ u32x4 pack8(const f32x4& v0, const f32x4& v1) { u32x4 w; w.x = cvtpk(v0[0], v0[1]); w.y = cvtpk(v0[2], v0[3]); w.z = cvtpk(v1[0], v1[1]); w.w = cvtpk(v1[2], v1[3]); return w; }
struct EpiStoreBf16 { bf16* O; int ldc;
    __device__ __forceinline__ void operator()(const f32x4 (&acc)[2][2][4][2], const pg8::Unit& u, int tid, int wr, int wc, int fr, int fq) const {
        const int row0 = u.pm * 256 + wr * 64 + fr, col0 = u.pn * 256 + wc * 32 + 8 * fq;
#pragma unroll
        for (int ai = 0; ai < 2; ++ai)
#pragma unroll
            for (int m = 0; m < 4; ++m) { bf16* rowp = O + (size_t)(row0 + ai * 128 + m * 16) * ldc + col0;
#pragma unroll
                for (int bj = 0; bj < 2; ++bj) *(u32x4*)(rowp + bj * 128) = pack8(acc[ai][bj][m][0], acc[ai][bj][m][1]); } }
};
struct EpiResidBf16 { const bf16* X; bf16* Y; float alpha;
    __device__ __forceinline__ void operator()(const f32x4 (&acc)[2][2][4][2], const pg8::Unit& u, int tid, int wr, int wc, int fr, int fq) const {
        const int row0 = u.pm * 256 + wr * 64 + fr, col0 = u.pn * 256 + wc * 32 + 8 * fq;
#pragma unroll
        for (int ai = 0; ai < 2; ++ai)
#pragma unroll
            for (int m = 0; m < 4; ++m) { const size_t base = (size_t)(row0 + ai * 128 + m * 16) * DM + col0;
#pragma unroll
                for (int bj = 0; bj < 2; ++bj) { const u32x4 xw = *(const u32x4*)(X + base + bj * 128);
                    const f32x4 x0 = (f32x4){bflo(xw.x), bfhi(xw.x), bflo(xw.y), bfhi(xw.y)}, x1 = (f32x4){bflo(xw.z), bfhi(xw.z), bflo(xw.w), bfhi(xw.w)};
                    *(u32x4*)(Y + base + bj * 128) = pack8(x0 * alpha + acc[ai][bj][m][0], x1 * alpha + acc[ai][bj][m][1]); } } }
};

#define XB_TMO      128
#define XB_XCNT(j)  (256  + 64 * (j))
#define XB_XSUB(j)  (1280 + 64 * (j))
#define XB_XGEN(j)  (2304 + 64 * (j))
#define XB_TOP      3328
#define XB_TOPGEN   3392
#define XCD_BAR_WORDS 3456
#define XB_SPIN_CAP (1u << 18)

__device__ __forceinline__ unsigned xb_ld(unsigned* p)              { return __hip_atomic_load(p, __ATOMIC_RELAXED, __HIP_MEMORY_SCOPE_AGENT); }
__device__ __forceinline__ unsigned xb_add(unsigned* p, unsigned v) { return __hip_atomic_fetch_add(p, v, __ATOMIC_RELAXED, __HIP_MEMORY_SCOPE_AGENT); }
__device__ __forceinline__ unsigned xb_xcc_id() { return (unsigned)__builtin_amdgcn_s_getreg((3 << 11) | 20) & 0xFu; }
#define XB_SPIN(cond, bar) do { unsigned _sp = 0; while (cond) { __builtin_amdgcn_s_sleep(1); \
    if ((++_sp & 255u) == 0u) { if (xb_ld(&(bar)[XB_TMO])) break; if (_sp > XB_SPIN_CAP) { atomicAdd(&(bar)[XB_TMO], 1u); break; } } } } while (0)

struct XcdBarrier {
    unsigned wv; unsigned* bar; unsigned x;
    volatile LAS unsigned* st;
};

#define XB_IS_T0(b) ((b).wv == 0u && lane_id_asm() == 0)
__device__ __forceinline__ XcdBarrier xcd_barrier_post(unsigned* bar, volatile LAS unsigned* st, unsigned wv) {
    XcdBarrier b; b.wv = wv; b.bar = bar; b.x = xb_xcc_id(); b.st = st;
    if (XB_IS_T0(b)) (void)xb_add(&bar[XB_XCNT(b.x)], 1u);
    return b;
}
__device__ __forceinline__ void xcd_barrier_complete(unsigned* bar, unsigned x, unsigned& nloc, unsigned& nx) {
    const unsigned G = gridDim.x * gridDim.y * gridDim.z;
    unsigned sum, cnt, mine, sp = 0u;
    for (;;) {
        sum = 0u; cnt = 0u; mine = 0u;
#pragma unroll
        for (unsigned j = 0; j < 16; ++j) { const unsigned c = xb_ld(&bar[XB_XCNT(j)]); sum += c; cnt += (c > 0u) ? 1u : 0u; mine = (j == x) ? c : mine; }
        if (sum == G) break;
        __builtin_amdgcn_s_sleep(1);
        if ((++sp & 255u) == 0u) { if (xb_ld(&bar[XB_TMO])) break; if (sp > XB_SPIN_CAP) { atomicAdd(&bar[XB_TMO], 1u); break; } }
    }
    nloc = mine > 0u ? mine : 1u; nx = cnt > 0u ? cnt : 1u;
}

__device__ __forceinline__ void xcd_barrier(const XcdBarrier& b) {
    asm volatile("s_waitcnt vmcnt(0)" ::: "memory");
    __syncthreads();
    if (XB_IS_T0(b)) {
        unsigned* bar = b.bar;
        __builtin_amdgcn_s_waitcnt(0);
        unsigned nloc = b.st[0], nx = b.st[1];
        if (nloc == 0u) { xcd_barrier_complete(bar, b.x, nloc, nx); b.st[0] = nloc; b.st[1] = nx; }
        const unsigned old = xb_add(&bar[XB_XSUB(b.x)], 1u);
        const unsigned gen = old / nloc;
        if (old + 1u == (gen + 1u) * nloc) {
            __builtin_amdgcn_fence(__ATOMIC_RELEASE, "agent");
            asm volatile("s_waitcnt vmcnt(0)" ::: "memory");
            const unsigned og = xb_add(&bar[XB_TOP], 1u);
            const unsigned tg = og / nx;
            if (og + 1u == (tg + 1u) * nx) xb_add(&bar[XB_TOPGEN], 1u);
            else XB_SPIN(xb_ld(&bar[XB_TOPGEN]) == tg, bar);
            __builtin_amdgcn_fence(__ATOMIC_ACQUIRE, "agent");
            xb_add(&bar[XB_XGEN(b.x)], 1u);
            asm volatile("s_waitcnt vmcnt(0)" ::: "memory");
        } else {
            XB_SPIN(xb_ld(&bar[XB_XGEN(b.x)]) == gen, bar);
            __builtin_amdgcn_fence(__ATOMIC_ACQUIRE, "agent");
            asm volatile("s_waitcnt vmcnt(0)" ::: "memory");
        }
    }
    __syncthreads();
}

struct Ctx {
    float* hf; unsigned char* ws; LAS unsigned char* lds;
    int tid, lane, wave, gw, ngw, G;
};
#define WSP(type, off) ((type*)(C.ws + (off)))
__device__ __forceinline__ Ctx fresh(const Ctx& C0) { Ctx C = C0; int w = C.wave; asm volatile("" : "+s"(w)); C.wave = w; C.lane = lane_id_asm(); C.tid = w * 64 + C.lane; C.gw = blockIdx.x * NWAVES + w; return C; }

__device__ __forceinline__ void ln_row(f32x4 (&v)[4], const float* g, const float* b, float* hfrow, bf16* hbrow, int lane) {
    float s = 0.f;
#pragma unroll
    for (int j = 0; j < 4; ++j) s += (v[j].x + v[j].y) + (v[j].z + v[j].w);
    const float mean = wave_sum_l(s, lane) * (1.f / DM); float s2 = 0.f;
#pragma unroll
    for (int j = 0; j < 4; ++j) { v[j] = v[j] - mean; s2 += (v[j].x * v[j].x + v[j].y * v[j].y) + (v[j].z * v[j].z + v[j].w * v[j].w); }
    const float rstd = 1.f / sqrtf(wave_sum_l(s2, lane) * (1.f / DM) + LN_EPS);
#pragma unroll
    for (int j = 0; j < 2; ++j) { const int c = 8 * lane + 512 * j;
        v[2 * j] = v[2 * j] * rstd * *(const f32x4*)(g + c) + *(const f32x4*)(b + c); v[2 * j + 1] = v[2 * j + 1] * rstd * *(const f32x4*)(g + c + 4) + *(const f32x4*)(b + c + 4);
        if (hfrow) { *(f32x4*)(hfrow + c) = v[2 * j]; *(f32x4*)(hfrow + c + 4) = v[2 * j + 1]; }
        u32x4 o; o.x = pk2(v[2 * j].x, v[2 * j].y); o.y = pk2(v[2 * j].z, v[2 * j].w); o.z = pk2(v[2 * j + 1].x, v[2 * j + 1].y); o.w = pk2(v[2 * j + 1].z, v[2 * j + 1].w); *(u32x4*)(hbrow + c) = o; }
}
__device__ __forceinline__ void ld8bf(const bf16* p, f32x4& a, f32x4& b) { const u32x4 w = *(const u32x4*)p; a = (f32x4){bflo(w.x), bfhi(w.x), bflo(w.y), bfhi(w.y)}; b = (f32x4){bflo(w.z), bfhi(w.z), bflo(w.w), bfhi(w.w)}; }
__device__ __forceinline__ f32x4 ld4bf(const bf16* p) { const u32x2 w = *(const u32x2*)p; return (f32x4){bflo(w.x), bfhi(w.x), bflo(w.y), bfhi(w.y)}; }

__device__ __forceinline__ void ph_prologue(const Args& A, const Ctx& C0) { const Ctx C = fresh(C0);
    LAS float* scr = (LAS float*)(C.lds + C.wave * CONV_SCR); int cbase = 0;
    for (int l = 0; l < NL; ++l) {
        unsigned char* wb = C.ws + WS_WSM + l * WSM_STRIDE;
        { const float* W = A.in[4] + (size_t)l * DM * DIN;
          auto f = [W](int k, int n) -> float { int src; float sc = 1.f;
              if (n < 1792) { src = n; if (n < 256) sc = SC32; else if (n >= 768 && n < 1024) sc = SC64; }
              else if (n < 2560) { src = 1952 + (n - 1792); if (n < 2048) sc = SC64; }
              else if (n < 2688) src = 1792 + (n - 2560);
              else if (n < 2720) { const int i = n - 2688; src = 1920 + (i & 1) * 16 + (i >> 1); }
              else if (n < 2724) src = n;
              else return 0.f;
              return W[(size_t)k * DIN + src] * sc; };
          conv_matrix(f, (bf16*)(wb + WO_WIN), NPROJ, DM, scr, C.lane, C.gw, C.ngw, cbase); }
        { const float* W = A.in[13] + (size_t)l * 4 * DM * DM;
          auto f = [W](int k, int R) -> float { const int grp = R >> 8, j = R & 255, n = ((j >> 7) << 1) | ((j >> 2) & 1), c = grp * 64 + ((j >> 5) & 3) * 16 + ((j >> 3) & 3) * 4 + (j & 3); return W[((size_t)n * DM + k) * DM + c]; };
          conv_matrix(f, (bf16*)(wb + WO_WG), 4 * DM, DM, scr, C.lane, C.gw, C.ngw, cbase); }
        { const float* W = A.in[15] + (size_t)l * 4 * 256 * DM;
          auto f = [W](int k, int n) -> float { return W[(size_t)k * DM + n]; };
          conv_matrix(f, (bf16*)(wb + WO_WB), DM, DM, scr, C.lane, C.gw, C.ngw, cbase); }
        { const float* W = A.in[16] + (size_t)l * DM * DM;
          auto f = [W](int k, int n) -> float { return W[(size_t)k * DM + n]; };
          conv_matrix(f, (bf16*)(wb + WO_WO), DM, DM, scr, C.lane, C.gw, C.ngw, cbase); }
        { const float* W = A.in[11] + (size_t)l * 256 * 384; const float* g = A.in[9] + l * 256;
          auto f = [W, g](int k, int n) -> float { if (n >= 384) return 0.f; const int h = n / 96, d = n % 96; int src = n;
              if (d >= 64) { const int i = d - 64; src = h * 96 + 64 + (i & 1) * 16 + (i >> 1); }
              return W[(size_t)k * 384 + src] * g[k] * SC96; };
          conv_matrix(f, (bf16*)(wb + WO_WUQ), 512, 256, scr, C.lane, C.gw, C.ngw, cbase); }
        { const float* W = A.in[12] + (size_t)l * 128 * 512; const float* g = A.in[10] + l * 128;
          auto f = [W, g](int k, int n) -> float { if (k >= 128) return 0.f; const int src = (n < 256) ? ((n >> 6) * 128 + (n & 63)) : (((n - 256) >> 6) * 128 + 64 + (n & 63));
              return W[(size_t)k * 512 + src] * g[k]; };
          conv_matrix(f, (bf16*)(wb + WO_WUKV), 512, 256, scr, C.lane, C.gw, C.ngw, cbase); }
    }
    { float* rope = WSP(float, WS_MISC + MO_ROPE); const int gt = C.gw * 64 + C.lane, ngt = C.ngw * 64;
      for (int i = gt; i < SEQ * 16; i += ngt) { const int pos = i >> 4, f = i & 15;
          const float invf = powf(10000.0f, -(float)f * 2.0f / 32.0f); const float ang = (float)pos * invf; float s, c; sincos_acc(ang, s, c);
          rope[2 * i] = c; rope[2 * i + 1] = s; }
      float* bt = WSP(float, WS_MISC + MO_T5);
      for (int i = gt; i < NL * 2 * 4 * 320; i += ngt) { const int rel = (i % 320) - 256, h = (i / 320) & 3, ty = (i / 1280) & 1, l = i / 2560; float v;
          if (ty == 0) { const int n = rel < 0 ? -rel : rel; int bk;
              if (n < 8) bk = n; else if (n < 12) bk = 8; else if (n < 16) bk = 9; else if (n < 23) bk = 10; else if (n < 32) bk = 11; else if (n < 46) bk = 12; else if (n < 64) bk = 13; else if (n < 91) bk = 14; else bk = 15;
              if (rel > 0) bk += 16;
              v = A.in[3][bk * 4 + h] - A.in[3][15 * 4 + h]; }
          else { const int rc = rel < -128 ? -128 : rel; const float* rb = A.in[8] + (size_t)l * 257 * 4; v = rb[(rc + 128) * 4 + h] - rb[h]; }
          bt[i] = v * LOG2E; } }
    { float* wrt = WSP(float, WS_MISC + MO_WRT); const int gt = C.gw * 64 + C.lane, ngt = C.ngw * 64;
      for (int i = gt; i < NL * 36 * DM; i += ngt) { const int k = i & (DM - 1), e = (i >> 10) % 36, l = i / (36 * DM);
          wrt[i] = e < 4 ? A.in[19][((size_t)l * DM + k) * 4 + e] : A.in[21][((size_t)l * DM + k) * 32 + (e - 4)]; } }
    bf16* hb = WSP(bf16, WS_HB);
    for (int m = 2 * C.gw; m < NT; m += 2 * C.ngw) { f32x4 v[2][4];
#pragma unroll
        for (int r = 0; r < 2; ++r)
#pragma unroll
            for (int j = 0; j < 4; ++j) v[r][j] = *(const f32x4*)(A.in[0] + (size_t)(m + r) * DM + 8 * C.lane + 512 * (j >> 1) + 4 * (j & 1));
#pragma unroll
        for (int r = 0; r < 2; ++r) ln_row(v[r], A.in[1], A.in[2], nullptr, hb + (size_t)(m + r) * DM, C.lane); }
}

__device__ __forceinline__ float log_sigmoid(float x) { return fminf(x, 0.f) - log1pf(expf(-fabsf(x))); }
struct EpiProj { bf16* O; float* rstd; const float* rope; bf16* mk; float* sum64; const float* bfg; LAS float* xl;
    __device__ __forceinline__ void operator()(const f32x4 (&acc)[2][2][4][2], const pg8::Unit& u, int tid, int wr, int wc, int fr, int fq) const {
        const int row0 = u.pm * 256 + wr * 64 + fr, col0 = u.pn * 256 + wc * 32 + 8 * fq; const int lane = tid & 63;
        const bool stat = (u.pn == 6 || u.pn == 10);
        float ssq[2][4];
#pragma unroll
        for (int ai = 0; ai < 2; ++ai)
#pragma unroll
            for (int m = 0; m < 4; ++m) { bf16* rowp = O + (size_t)(row0 + ai * 128 + m * 16) * NPROJ + col0; float q = 0.f;
#pragma unroll
                for (int bj = 0; bj < 2; ++bj) { const u32x4 w = pack8(acc[ai][bj][m][0], acc[ai][bj][m][1]); *(u32x4*)(rowp + bj * 128) = w;
                    if (stat && (u.pn == 6 || bj == 0)) q += (bflo(w.x) * bflo(w.x) + bfhi(w.x) * bfhi(w.x)) + (bflo(w.y) * bflo(w.y) + bfhi(w.y) * bfhi(w.y)) + (bflo(w.z) * bflo(w.z) + bfhi(w.z) * bfhi(w.z)) + (bflo(w.w) * bflo(w.w) + bfhi(w.w) * bfhi(w.w));
                    if (u.pn == 10 && bj == 1) {
                        if (wc == 0) {
                            const int row = row0 + ai * 128 + m * 16, pos = row & (SEQ - 1); const float* rp = rope + ((size_t)pos * 16 + 4 * fq) * 2; const f32x4 ra = *(const f32x4*)rp, rb = *(const f32x4*)(rp + 4);
                            const f32x4 t0 = {bflo(w.x), bfhi(w.x), bflo(w.y), bfhi(w.y)}, t1 = {bflo(w.z), bfhi(w.z), bflo(w.w), bfhi(w.w)};
                            const f32x4 r0 = {t0[0] * ra[0] - t0[1] * ra[1], t0[0] * ra[1] + t0[1] * ra[0], t0[2] * ra[2] - t0[3] * ra[3], t0[2] * ra[3] + t0[3] * ra[2]};
                            const f32x4 r1 = {t1[0] * rb[0] - t1[1] * rb[1], t1[0] * rb[1] + t1[1] * rb[0], t1[2] * rb[2] - t1[3] * rb[3], t1[2] * rb[3] + t1[3] * rb[2]};
                            const u32x4 ow = pack8(r0, r1);
#pragma unroll
                            for (int h = 0; h < 4; ++h) *(u32x4*)(mk + (size_t)row * 384 + h * 96 + 64 + 8 * fq) = ow; } } }
                ssq[ai][m] = q; }
        if (u.pn == 10 && wc == 1) {
#pragma unroll
            for (int ai = 0; ai < 2; ++ai) { f32x4 sm = {0.f, 0.f, 0.f, 0.f};
#pragma unroll
                for (int m = 0; m < 4; ++m) { const u32x4 w = pack8(acc[ai][1][m][0], acc[ai][1][m][1]); const float x[4] = {bflo(w.x), bfhi(w.x), bflo(w.y), bfhi(w.y)};
#pragma unroll
                    for (int h = 0; h < 4; ++h) sm[h] += log_sigmoid(x[h] + bfg[h]) * LOG2E; }
#pragma unroll
                for (int h = 0; h < 4; ++h) {
#pragma unroll
                    for (int o = 1; o < 16; o <<= 1) sm[h] += shfl_xor_l(sm[h], o, lane); }
                if (lane == 0) *(f32x4*)(sum64 + (size_t)((u.pm * 2 + ai) * 2 + wr) * 4) = sm; } }
        if (stat) {
#pragma unroll
            for (int ai = 0; ai < 2; ++ai)
#pragma unroll
                for (int m = 0; m < 4; ++m) { float q = ssq[ai][m]; q += shfl_xor_l(q, 16, lane); q += shfl_xor_l(q, 32, lane); if (fq == 0) xl[wc * 256 + ai * 128 + wr * 64 + m * 16 + fr] = q; }
            asm volatile("s_waitcnt lgkmcnt(0)\n\ts_barrier" ::: "memory");
            if (tid < 256) { const float t = (xl[tid] + xl[256 + tid]) + (xl[512 + tid] + xl[768 + tid]);
                if (u.pn == 6) rstd[2 * (u.pm * 256 + tid)] = 1.f / sqrtf(t * (1.f / 256) + LN_EPS); else rstd[2 * (u.pm * 256 + tid) + 1] = 1.f / sqrtf(t * (1.f / 128) + LN_EPS); }
            asm volatile("s_waitcnt lgkmcnt(0)\n\ts_barrier" ::: "memory"); }
    }
};
__device__ __forceinline__ void ph_proj(const Args& A, const Ctx& C0, int l) { const Ctx C = fresh(C0);
    GridSched S; S.A = (const char*)WSP(bf16, WS_HB); S.B = (const char*)WSP(bf16, WS_WSM + l * WSM_STRIDE + WO_WIN); S.nM = NT / 256; S.nN = NPROJ / 256; S.nt = DM / 64; S.G = C.G; S.c = blockIdx.x; S.lda = DM * 2; S.ldb = DM * 2;
    EpiProj E{WSP(bf16, WS_R1), WSP(float, WS_MISC + MO_RSTD), WSP(float, WS_MISC + MO_ROPE), WSP(bf16, WS_R2 + 24 * MiB), WSP(float, WS_MISC + MO_SUM64), A.in[5] + l * 4, (LAS float*)(C.lds + LDS_TAB)};
    pg8::gemm_phase<false>(C.lds, C.tid, DM * 2, DM * 2, S, E);
}

__device__ __forceinline__ void fox_tables(const Args& A, const Ctx& C, int l) {
    const bf16* proj = WSP(bf16, WS_R1); const float* sum64 = WSP(float, WS_MISC + MO_SUM64); float* cum = WSP(float, WS_MISC + MO_CUM); const float* bf = A.in[5] + l * 4;
    LAS float* wt = (LAS float*)(C.lds + LDS_TAB);
    for (int blk = blockIdx.x; blk < NT / 128; blk += C.G) { const int b = blk / (SEQ / 128);
        __syncthreads();
        if (C.tid < 128) { const int idx = b * (SEQ / 64) + C.tid; f32x4 p = idx < blk * 2 ? *(const f32x4*)(sum64 + (size_t)idx * 4) : (f32x4){0.f, 0.f, 0.f, 0.f};
#pragma unroll
            for (int h = 0; h < 4; ++h) p[h] = wave_sum_l(p[h], C.lane);
            if (C.lane == 0) *(LAS f32x4*)(wt + C.wave * 4) = p; }
        float ls[4] = {0.f, 0.f, 0.f, 0.f}, inc[4];
        if (C.tid < 128) { const u32x2 ff = *(const u32x2*)(proj + (size_t)(blk * 128 + C.tid) * NPROJ + PC_FF); const float x[4] = {bflo(ff.x), bfhi(ff.x), bflo(ff.y), bfhi(ff.y)};
#pragma unroll
            for (int h = 0; h < 4; ++h) ls[h] = log_sigmoid(x[h] + bf[h]) * LOG2E; }
#pragma unroll
        for (int h = 0; h < 4; ++h) { float v = ls[h];
#pragma unroll
            for (int o = 1; o < 64; o <<= 1) { const float y = shfl_up_l(v, o, C.lane); if (C.lane >= o) v += y; }
            inc[h] = v; if (C.tid == 63) wt[8 + h] = v; }
        __syncthreads();
        if (C.tid < 128) { const int t = (blk * 128 + C.tid) & (SEQ - 1);
#pragma unroll
            for (int h = 0; h < 4; ++h) cum[(size_t)(b * 4 + h) * SEQ + t] = (wt[h] + wt[4 + h]) + (C.wave == 1 ? wt[8 + h] : 0.f) + inc[h]; }
        float mq2 = 0.f, mk2 = 0.f;
        for (int i = 0; i < 16; ++i) { const bf16* row = proj + (size_t)(blk * 128 + C.wave * 16 + i) * NPROJ;
            const u32x2 fq = *(const u32x2*)(row + PC_FQ + 4 * C.lane), fk = *(const u32x2*)(row + PC_FK + 4 * C.lane);
            float a = bflo(fq.x) * bflo(fq.x) + bfhi(fq.x) * bfhi(fq.x) + bflo(fq.y) * bflo(fq.y) + bfhi(fq.y) * bfhi(fq.y);
            float b2 = bflo(fk.x) * bflo(fk.x) + bfhi(fk.x) * bfhi(fk.x) + bflo(fk.y) * bflo(fk.y) + bfhi(fk.y) * bfhi(fk.y);
#pragma unroll
            for (int o = 1; o < 16; o <<= 1) { a += shfl_xor_l(a, o, C.lane); b2 += shfl_xor_l(b2, o, C.lane); }
            mq2 = fmaxf(mq2, a); mk2 = fmaxf(mk2, b2); }
        unsigned* qkm = WSP(unsigned, WS_CTL) + CW_QKMAX + l * 32;
        if ((C.lane & 15) == 0) { atomicMax(qkm + b * 4 + (C.lane >> 4), __float_as_uint(mq2)); atomicMax(qkm + 16 + b * 4 + (C.lane >> 4), __float_as_uint(mk2)); }
    }
    __syncthreads();
}

struct MlaSched : pg8::PlainRows { const char* proj; const char* Wq; const char* Wkv; int G, c;
    __device__ __forceinline__ bool next(int i, pg8::Unit& u) const { const int cx = (G & 7) == 0 ? (c & 7) * (G >> 3) + (c >> 3) : c; const int L = i * G + cx; if (L >= (NT / 256) * 4) return false;
        const int pm = L >> 2, kind = (L >> 1) & 1, pn = L & 1; u.pm = pm; u.pn = pn; u.nt = 4; u.aux = kind;
        u.A = proj + (size_t)pm * 256 * (NPROJ * 2) + (kind ? PC_CKV : PC_CQ) * 2; u.B = (kind ? Wkv : Wq) + (size_t)pn * 256 * 512; return true; } };
struct EpiMla { const float* rstd; const float* rope; bf16* mq; bf16* mk; bf16* mv;
    __device__ __forceinline__ void operator()(const f32x4 (&acc)[2][2][4][2], const pg8::Unit& u, int tid, int wr, int wc, int fr, int fq) const {
        const int row0 = u.pm * 256 + wr * 64 + fr;
        if (u.aux == 0) {
#pragma unroll
            for (int ai = 0; ai < 2; ++ai)
#pragma unroll
                for (int m = 0; m < 4; ++m) { asm volatile("" ::: "memory"); const int row = row0 + ai * 128 + m * 16; const float rs = rstd[2 * row]; const int pos = row & (SEQ - 1);
#pragma unroll
                    for (int bj = 0; bj < 2; ++bj) { const int col0 = u.pn * 256 + bj * 128 + wc * 32 + 8 * fq; f32x4 v0 = acc[ai][bj][m][0] * rs, v1 = acc[ai][bj][m][1] * rs;
                        if (col0 < 384) { const int d0 = col0 % 96;
                            if (d0 >= 64) { const float* rp = rope + ((size_t)pos * 16 + ((d0 - 64) >> 1)) * 2; const f32x4 ra = *(const f32x4*)rp, rb = *(const f32x4*)(rp + 4);
                                const f32x4 t0 = v0, t1 = v1;
                                v0[0] = t0[0] * ra[0] - t0[1] * ra[1]; v0[1] = t0[0] * ra[1] + t0[1] * ra[0]; v0[2] = t0[2] * ra[2] - t0[3] * ra[3]; v0[3] = t0[2] * ra[3] + t0[3] * ra[2];
                                v1[0] = t1[0] * rb[0] - t1[1] * rb[1]; v1[1] = t1[0] * rb[1] + t1[1] * rb[0]; v1[2] = t1[2] * rb[2] - t1[3] * rb[3]; v1[3] = t1[2] * rb[3] + t1[3] * rb[2]; }
                            *(u32x4*)(mq + (size_t)row * 384 + col0) = pack8(v0, v1); } } }
        } else {
#pragma unroll
            for (int ai = 0; ai < 2; ++ai)
#pragma unroll
                for (int m = 0; m < 4; ++m) { asm volatile("" ::: "memory"); const int row = row0 + ai * 128 + m * 16; const float rs = rstd[2 * row + 1];
#pragma unroll
                    for (int bj = 0; bj < 2; ++bj) { const int col0 = u.pn * 256 + bj * 128 + wc * 32 + 8 * fq; const f32x4 v0 = acc[ai][bj][m][0] * rs, v1 = acc[ai][bj][m][1] * rs;
                        if (col0 < 256) *(u32x4*)(mk + (size_t)row * 384 + (col0 >> 6) * 96 + (col0 & 63)) = pack8(v0, v1); else *(u32x4*)(mv + (size_t)row * 256 + (col0 - 256)) = pack8(v0, v1); } }
        } }
};
__device__ __forceinline__ void ph_mla_up(const Args& A, const Ctx& C0, int l) { const Ctx C = fresh(C0);
    fox_tables(A, C, l);
    MlaSched S; S.proj = (const char*)WSP(bf16, WS_R1); S.Wq = (const char*)WSP(bf16, WS_WSM + l * WSM_STRIDE + WO_WUQ); S.Wkv = (const char*)WSP(bf16, WS_WSM + l * WSM_STRIDE + WO_WUKV); S.G = C.G; S.c = blockIdx.x;
    EpiMla E{WSP(float, WS_MISC + MO_RSTD), WSP(float, WS_MISC + MO_ROPE), WSP(bf16, WS_R2), WSP(bf16, WS_R2 + 24 * MiB), WSP(bf16, WS_R2 + 48 * MiB)};
    pg8::gemm_phase<false>(C.lds, C.tid, NPROJ * 2, 512, S, E);
}

typedef short s16x4 __attribute__((ext_vector_type(4)));
typedef __attribute__((address_space(3))) const char* lds_cptr;
constexpr int AT_K = 0, AT_KSLOT = 16384, AT_V = 49152, AT_VSLOT = 8192, AT_TAB = 81920, AT_CK = 83968;
constexpr float AT_THR = 8.f;
__device__ __forceinline__ s16x4 vtr(lds_cptr p) { return __builtin_bit_cast(s16x4, __builtin_amdgcn_ds_read_tr16_b64_v4i16((__attribute__((address_space(3))) s16x4*)p)); }
__device__ __forceinline__ float swapmax(float m) { auto rr = __builtin_amdgcn_permlane32_swap(__float_as_uint(m), __float_as_uint(m), false, false); return fmaxf(__uint_as_float(rr[0]), __uint_as_float(rr[1])); }
__device__ __forceinline__ float swapsum(float m) { auto rr = __builtin_amdgcn_permlane32_swap(__float_as_uint(m), __float_as_uint(m), false, false); return __uint_as_float(rr[0]) + __uint_as_float(rr[1]); }
#define AT_WAITBAR(N) asm volatile("s_waitcnt vmcnt(" #N ") lgkmcnt(0)\n\ts_barrier" ::: "memory")
#define MX3(a, b, c) __builtin_fmaxf(__builtin_fmaxf((a), (b)), (c))

struct AttnSrc { const bf16* Q; const bf16* K; const bf16* V; int qp, kp, vp; };

template <int TYPE> __device__ __forceinline__ void attn_unit(const Ctx& C, const AttnSrc& S, int qb, const float* gtab, const float* cumT, bf16* Odst, float lam_full, float lam_init, const float* dng, float bqk) {
    constexpr int DQ = TYPE == 2 ? 96 : 64, NMAP = TYPE == 0 ? 2 : 1, DMAP = DQ / NMAP, NKS = DMAP / 16;
    int lane_ = C.lane, wid_ = C.wave; asm volatile("" : "+v"(lane_), "+s"(wid_));
    const int lane = lane_, r32 = lane & 31, hi = lane >> 5, wid = wid_;
    const int q0 = qb * 256, qw = q0 + wid * 32, q = qw + r32, cw = qw >> 6;
    const int thi = 4 * qb + 3, thi_w = cw; const bool lag = wid >= 4;
    int tlo = TYPE == 1 ? (4 * qb - 8 > 0 ? 4 * qb - 8 : 0) : 0, tlo_w = TYPE == 1 ? (cw - 8 > 0 ? cw - 8 : 0) : 0;
    if (TYPE == 3) {
        const float d0 = cumT[q0] + 2.f * bqk + 40.f; const int t0 = lane, t1 = 64 + lane;
        const bool ok0 = (t0 <= thi) && (d0 - cumT[t0 * 64 + 63] >= 0.f), ok1 = (t1 <= thi) && (d0 - cumT[t1 * 64 + 63] >= 0.f);
        const unsigned long long m0 = __ballot(ok0), m1 = __ballot(ok1);
        tlo = m0 ? (int)__builtin_ctzll(m0) : (m1 ? 64 + (int)__builtin_ctzll(m1) : thi); tlo = __builtin_amdgcn_readfirstlane(tlo); if (tlo > 4 * qb) tlo = 4 * qb; tlo_w = tlo; }
    const unsigned lds0 = (unsigned)(uintptr_t)C.lds;
    LAS float* tab = (LAS float*)(C.lds + AT_TAB); LAS float* ckl = (LAS float*)(C.lds + AT_CK);
    const unsigned koff = (unsigned)(lane * S.kp + wid * 8) * 2u, voffv = (unsigned)((16 * (wid & 3) + (lane >> 2)) * S.vp + (wid >> 2) * 32 + (lane & 3) * 8) * 2u;
    const int k2 = (wid < 4 ? 8 : 4) * 16;
    const unsigned kdst = lds0 + AT_K + wid * 1024, vdst = lds0 + AT_V + wid * 1024;
#define AT_ISSUE_K(t, ks) do { const char* kb_ = (const char*)S.K + (size_t)(t) * 128 * S.kp; \
        glds16(kb_, koff, (unsigned)__builtin_amdgcn_readfirstlane(kdst + (ks) * AT_KSLOT)); \
        if (TYPE == 2) glds16(kb_ + k2, koff, (unsigned)__builtin_amdgcn_readfirstlane(kdst + (ks) * AT_KSLOT + 8192)); } while (0)
#define AT_ISSUE_V(t, vs) glds16((const char*)S.V + (size_t)(t) * 128 * S.vp, voffv, (unsigned)__builtin_amdgcn_readfirstlane(vdst + (vs) * AT_VSLOT))
    constexpr bool KPIPE = false, FOLD = true;
    AT_ISSUE_K(tlo, 0); AT_ISSUE_V(tlo, 0);
    if (tlo + 1 <= thi) { AT_ISSUE_K(tlo + 1, 1); AT_ISSUE_V(tlo + 1, 1); }
    if (KPIPE && tlo + 2 <= thi) AT_ISSUE_K(tlo + 2, 2);
    bf16x8 qr[NMAP][NKS];
#pragma unroll
    for (int m = 0; m < NMAP; ++m)
#pragma unroll
        for (int d0 = 0; d0 < NKS; ++d0) qr[m][d0] = *(const bf16x8*)(S.Q + (size_t)q * S.qp + m * DMAP + d0 * 16 + hi * 8);
    const int tid = wid * 64 + lane;
    if (TYPE == 0 || TYPE == 1) { if (tid < 320) tab[tid] = gtab[tid]; }
    float cq = 0.f;
    if (TYPE == 3) { for (int i = tid; i < q0 + 256 - tlo * 64; i += NTHR) ckl[i] = cumT[tlo * 64 + i]; cq = cumT[q]; }
    f32x16 o[NMAP][2], negm; float mhat = 0.f, lsum[NMAP]; u32x4 pw[NMAP][4];
#pragma unroll
    for (int r = 0; r < 16; ++r) negm[r] = cq;
#pragma unroll
    for (int m = 0; m < NMAP; ++m) { o[m][0] = f32x16{}; o[m][1] = f32x16{}; lsum[m] = 0.f;
#pragma unroll
        for (int i = 0; i < 4; ++i) pw[m][i] = (u32x4){0u, 0u, 0u, 0u}; }
#pragma unroll
    for (int m = 0; m < NMAP; ++m)
#pragma unroll
        for (int d0 = 0; d0 < NKS; ++d0) asm volatile("" : "+v"(qr[m][d0]));
    asm volatile("" : "+v"(cq));
    const lds_cptr kp0 = (lds_cptr)C.lds + AT_K + hi * 1024 + r32 * 16;
    const lds_cptr vp0 = (lds_cptr)C.lds + AT_V + ((lane >> 4) & 1) * 32 + (lane & 3) * 8 + (4 * hi + ((lane & 15) >> 2)) * 64;
    s16x4 vl[8], vh[8];
#define AT_VLOAD(vs_, i0, i1) do { const lds_cptr vp_ = vp0 + (vs_) * AT_VSLOT; \
        _Pragma("unroll") for (int i_ = (i0); i_ < (i1); ++i_) { vl[i_] = vtr(vp_ + ((i_ >> 2) * 4096 + (i_ & 3) * 1024)); vh[i_] = vtr(vp_ + ((i_ >> 2) * 4096 + (i_ & 3) * 1024 + 512)); } } while (0)
#define AT_VF(i_) (bf16x8){vl[i_][0], vl[i_][1], vl[i_][2], vl[i_][3], vh[i_][0], vh[i_][1], vh[i_][2], vh[i_][3]}
#define AT_PV(m, ALT) do { __builtin_amdgcn_s_setprio(1); \
        if (ALT) { _Pragma("unroll") for (int ks_ = 0; ks_ < 4; ++ks_) { o[m][0] = MFMA32(AT_VF(ks_), __builtin_bit_cast(bf16x8, pw[m][ks_]), o[m][0]); o[m][1] = MFMA32(AT_VF(4 + ks_), __builtin_bit_cast(bf16x8, pw[m][ks_]), o[m][1]); } } \
        else { _Pragma("unroll") for (int ks_ = 0; ks_ < 4; ++ks_) o[m][0] = MFMA32(AT_VF(ks_), __builtin_bit_cast(bf16x8, pw[m][ks_]), o[m][0]); \
               _Pragma("unroll") for (int ks_ = 0; ks_ < 4; ++ks_) o[m][1] = MFMA32(AT_VF(4 + ks_), __builtin_bit_cast(bf16x8, pw[m][ks_]), o[m][1]); } \
        __builtin_amdgcn_s_setprio(0); } while (0)
    int ks = 0, vs = 0, vprev = 0; bool pend = false;
    bf16x8 kf[1][NKS][2];
#define AT_KLOAD(ks_) do { const lds_cptr kp_ = kp0 + (ks_) * AT_KSLOT; \
        _Pragma("unroll") for (int d0 = 0; d0 < NKS; ++d0) { const int cb = d0 * 2048; \
            kf[0][d0][0] = *(const __attribute__((address_space(3))) bf16x8*)(kp_ + cb); kf[0][d0][1] = *(const __attribute__((address_space(3))) bf16x8*)(kp_ + cb + 512); } } while (0)
    if (KPIPE) { AT_WAITBAR(0);
        if (tlo_w == tlo) AT_KLOAD(0); }
    for (int t = tlo; t <= thi; ++t) {
        if (!KPIPE || t > tlo) { if (t + 1 <= thi) { if (TYPE == 2) AT_WAITBAR(3); else AT_WAITBAR(2); } else AT_WAITBAR(0); }
        if (KPIPE) { if (t + 3 <= thi) AT_ISSUE_K(t + 3, ks); }
        else if (t + 2 <= thi) AT_ISSUE_K(t + 2, ks >= 1 ? ks - 1 : 2);
        if (t + 2 <= thi) AT_ISSUE_V(t + 2, (vs + 2) & 3);
        if (pend) { AT_VLOAD(vprev, 0, 8); AT_PV(NMAP - 1, true); pend = false; }
        const int ksn = ks == 2 ? 0 : ks + 1;
        if (t >= tlo_w && t <= thi_w) {
            const bool first = (t == tlo_w);
#pragma unroll
            for (int m = 0; m < NMAP; ++m) {
                const bool pvnow = !lag || m < NMAP - 1;
                __builtin_amdgcn_sched_barrier(0);
                f32x16 s0 = FOLD ? negm : f32x16{}, s1 = FOLD ? negm : f32x16{};
                if (!KPIPE) { const lds_cptr kp_ = kp0 + ks * AT_KSLOT;
#pragma unroll
                    for (int d0 = 0; d0 < NKS; ++d0) { const int cb = (m * NKS + d0) * 2048;
                        kf[0][d0][0] = *(const __attribute__((address_space(3))) bf16x8*)(kp_ + cb); kf[0][d0][1] = *(const __attribute__((address_space(3))) bf16x8*)(kp_ + cb + 512); }
                    if (pvnow) AT_VLOAD(vs, 0, 4);
                    __builtin_amdgcn_sched_barrier(0); }
                __builtin_amdgcn_s_setprio(1);
#pragma unroll
                for (int d0 = 0; d0 < NKS; ++d0) { s0 = MFMA32(kf[0][d0][0], qr[m][d0], s0); s1 = MFMA32(kf[0][d0][1], qr[m][d0], s1); }
                __builtin_amdgcn_s_setprio(0);
                if (KPIPE) { if (pvnow) AT_VLOAD(vs, 0, 4);
                    if (t + 1 <= thi_w) AT_KLOAD(ksn); }
                if (TYPE == 0 || TYPE == 1) { if (t * 64 + 63 - qw > -128) { const LAS float* tb = tab + (t * 64 - q + 256);
#pragma unroll
                    for (int r = 0; r < 16; ++r) { s0[r] += tb[crow(r, hi)]; s1[r] += tb[32 + crow(r, hi)]; } } }
                if (TYPE == 3) { const LAS float* cb = ckl + (t - tlo) * 64 + 4 * hi;
#pragma unroll
                    for (int g = 0; g < 4; ++g) { const f32x4 c0 = *(const LAS f32x4*)(cb + 8 * g), c1 = *(const LAS f32x4*)(cb + 32 + 8 * g);
#pragma unroll
                        for (int i = 0; i < 4; ++i) { s0[4 * g + i] -= c0[i]; s1[4 * g + i] -= c1[i]; } }
                    if (t == cw) { const int kb = t * 64 + 4 * hi;
#pragma unroll
                        for (int r = 0; r < 16; ++r) { const int kv = kb + (r & 3) + 8 * (r >> 2); if (kv > q) s0[r] = -INFINITY; if (kv + 32 > q) s1[r] = -INFINITY; } } }
                float ra = MX3(s0[0], s0[1], s1[0]), rb = MX3(s0[2], s0[3], s1[1]); ra = MX3(ra, s1[2], s1[3]);
#pragma unroll
                for (int r = 4; r < 16; r += 4) { ra = MX3(ra, s0[r], s0[r + 1]); rb = MX3(rb, s0[r + 2], s0[r + 3]); ra = MX3(ra, s1[r], s1[r + 1]); rb = MX3(rb, s1[r + 2], s1[r + 3]); }
                const float rm = swapmax(fmaxf(ra, rb)) - (FOLD ? 0.f : mhat - cq);
                const bool fst = first && m == 0;
                if (fst || __any(rm > AT_THR)) { const float dl = fst ? rm : fmaxf(rm, 0.f); mhat += dl;
                    if (FOLD) {
#pragma unroll
                        for (int r = 0; r < 16; ++r) { s0[r] -= dl; s1[r] -= dl; negm[r] = cq - mhat; } }
                    if (!fst) { const float f = exp2f(-dl);
#pragma unroll
                        for (int mm = 0; mm < NMAP; ++mm) { lsum[mm] *= f;
#pragma unroll
                            for (int r = 0; r < 16; ++r) { o[mm][0][r] *= f; o[mm][1][r] *= f; } } } }
                float sacc = 0.f; const float sh = FOLD ? 0.f : mhat - cq;
#pragma unroll
                for (int r = 0; r < 16; ++r) { s0[r] = __builtin_amdgcn_exp2f(FOLD ? s0[r] : s0[r] - sh); s1[r] = __builtin_amdgcn_exp2f(FOLD ? s1[r] : s1[r] - sh); sacc += s0[r] + s1[r]; }
                lsum[m] += sacc;
                if (pvnow) AT_VLOAD(vs, 4, 8);
#pragma unroll
                for (int i = 0; i < 4; ++i) { pw[m][0][i] = cvtpk_dep(s0[2 * i], s0[2 * i + 1], sacc); pw[m][1][i] = cvtpk_dep(s0[8 + 2 * i], s0[8 + 2 * i + 1], sacc); pw[m][2][i] = cvtpk_dep(s1[2 * i], s1[2 * i + 1], sacc); pw[m][3][i] = cvtpk_dep(s1[8 + 2 * i], s1[8 + 2 * i + 1], sacc); }
                if (pvnow) AT_PV(m, false);
            }
            if (lag) { pend = true; vprev = vs; }
        } else if (KPIPE && t + 1 == tlo_w) AT_KLOAD(ksn);
        ks = ksn; vs = (vs + 1) & 3;
    }
    if (pend) { AT_VLOAD(vprev, 0, 8); AT_PV(NMAP - 1, true); }
    float inv[NMAP];
#pragma unroll
    for (int m = 0; m < NMAP; ++m) inv[m] = 1.f / swapsum(lsum[m]);
    f32x16 res[2];
    if (TYPE == 0) { float ss = 0.f;
#pragma unroll
        for (int dh = 0; dh < 2; ++dh)
#pragma unroll
            for (int r = 0; r < 16; ++r) { const float v = o[0][dh][r] * inv[0] - lam_full * (o[NMAP - 1][dh][r] * inv[NMAP - 1]); res[dh][r] = v; ss += v * v; }
        ss = swapsum(ss); const float rs = (1.f / sqrtf(ss * (1.f / 64) + LN_EPS)) * (1.f - lam_init);
#pragma unroll
        for (int dh = 0; dh < 2; ++dh)
#pragma unroll
            for (int r = 0; r < 16; ++r) res[dh][r] = res[dh][r] * rs * dng[32 * dh + crow(r, hi)];
    } else {
#pragma unroll
        for (int dh = 0; dh < 2; ++dh)
#pragma unroll
            for (int r = 0; r < 16; ++r) res[dh][r] = o[0][dh][r] * inv[0];
    }
    bf16* orow = Odst + (size_t)q * DM;
#pragma unroll
    for (int dh = 0; dh < 2; ++dh)
#pragma unroll
        for (int g = 0; g < 4; ++g) { u32x2 w; w.x = cvtpk(res[dh][4 * g], res[dh][4 * g + 1]); w.y = cvtpk(res[dh][4 * g + 2], res[dh][4 * g + 3]); *(u32x2*)(orow + 32 * dh + 8 * g + 4 * hi) = w; }
    asm volatile("s_waitcnt lgkmcnt(0)\n\ts_barrier" ::: "memory");
#undef AT_ISSUE_K
#undef AT_ISSUE_V
#undef AT_KLOAD
#undef AT_PV
#undef AT_VLOAD
#undef AT_VF
}

__device__ __forceinline__ void ph_conv_experts(const Args& A, const Ctx& C0, int l) { const Ctx C = fresh(C0);
    LAS float* scr = (LAS float*)(C.lds + C.wave * CONV_SCR);
    const float* W1b = A.in[23] + (size_t)l * NEXP * DM * DEXP; const float* W3b = A.in[24] + (size_t)l * NEXP * DM * DEXP; const float* W2b = A.in[25] + (size_t)l * NEXP * DEXP * DM;
    const long long d31 = (const char*)W3b - (const char*)W1b;
    for (int g = C.gw; g < NEXP * 384; g += C.ngw) { const int e = g / 384, r = g % 384; bf16* wb = WSP(bf16, WS_WEXP) + (size_t)e * 3 * DM * DEXP;
        if (r < 256) { const float* W1 = W1b + (size_t)e * DM * DEXP;
            auto f = [W1, d31](int k, int n) -> float { const long long o = (n & 128) ? d31 : 0ll; return ((const float*)((const char*)W1 + o))[(size_t)k * DEXP + (n >> 8) * 128 + (n & 127)]; };
            transpose_item(f, wb, DM, (r >> 4) * 64, (r & 15) * 64, scr, C.lane); }
        else { const int r2 = r - 256; const float* W2 = W2b + (size_t)e * DEXP * DM;
            auto f = [W2](int k, int n) -> float { return W2[(size_t)k * DM + n]; };
            transpose_item(f, wb + (size_t)2 * DM * DEXP, DEXP, (r2 >> 3) * 64, (r2 & 7) * 64, scr, C.lane); } }
}
__device__ __forceinline__ void ph_attn(const Args& A, const Ctx& C0, int l) { const Ctx C = fresh(C0);
    const bf16* proj = WSP(bf16, WS_R1); const bf16* mq = WSP(bf16, WS_R2); const bf16* mk = WSP(bf16, WS_R2 + 24 * MiB); const bf16* mv = WSP(bf16, WS_R2 + 48 * MiB);
    const float* cumT = WSP(float, WS_MISC + MO_CUM); const float* btab = WSP(float, WS_MISC + MO_T5) + (size_t)l * 2 * 4 * 320; bf16* O = WSP(bf16, WS_R3);
    float lam_full; const float lam_init = 0.8f - 0.6f * expf(-0.3f * (float)l);
    { const float* lm = A.in[6] + l * 128; float a = 0.f, b = 0.f; for (int i = 0; i < 32; ++i) { a += lm[i] * lm[32 + i]; b += lm[64 + i] * lm[96 + i]; } lam_full = expf(a) - expf(b) + lam_init; }
    const float* dng = A.in[7] + l * 64;
    const int vcu = (C.G % 8 == 0) ? ((int)(blockIdx.x % 8) * (C.G / 8) + (int)(blockIdx.x / 8)) : (int)blockIdx.x;
    const int conv_at = (int)(blockIdx.x & 7);
    for (int up = vcu; up < 256 + C.G; up += C.G) {
        const bool has = up < 256; const int bh = (up >> 4) & 15, j = up & 15, b = bh >> 2, h = bh & 3; const size_t rb = (size_t)b * SEQ;
        const unsigned* qkm = WSP(unsigned, WS_CTL) + CW_QKMAX + l * 32; const float bqk = sqrtf(__uint_as_float(__hip_atomic_load(qkm + bh, __ATOMIC_RELAXED, __HIP_MEMORY_SCOPE_AGENT)) * __uint_as_float(__hip_atomic_load(qkm + 16 + bh, __ATOMIC_RELAXED, __HIP_MEMORY_SCOPE_AGENT))) * 1.001f;
        for (int s8 = 0; s8 < 8; ++s8) { const int k = s8 >> 2, ty = s8 & 3, qb = k ? 31 - j : j;
            if (has) {
                if (ty == 0) { AttnSrc S{proj + rb * NPROJ + PC_DQ + h * 64, proj + rb * NPROJ + PC_DK + h * 64, proj + rb * NPROJ + PC_DV + h * 64, NPROJ, NPROJ, NPROJ};
                    attn_unit<0>(C, S, qb, btab + h * 320, nullptr, O + rb * DM + 0 * 256 + h * 64, lam_full, lam_init, dng, 0.f); }
                else if (ty == 1) { AttnSrc S{mq + rb * 384 + h * 96, mk + rb * 384 + h * 96, mv + rb * 256 + h * 64, 384, 384, 256};
                    attn_unit<2>(C, S, qb, nullptr, nullptr, O + rb * DM + 2 * 256 + h * 64, 0.f, 0.f, nullptr, 0.f); }
                else if (ty == 2) { AttnSrc S{proj + rb * NPROJ + PC_FQ + h * 64, proj + rb * NPROJ + PC_FK + h * 64, proj + rb * NPROJ + PC_FV + h * 64, NPROJ, NPROJ, NPROJ};
                    attn_unit<3>(C, S, qb, nullptr, cumT + (size_t)bh * SEQ, O + rb * DM + 3 * 256 + h * 64, 0.f, 0.f, nullptr, bqk); }
                else { AttnSrc S{proj + rb * NPROJ + PC_BQ + h * 64, proj + rb * NPROJ + PC_BK + h * 64, proj + rb * NPROJ + PC_BV + h * 64, NPROJ, NPROJ, NPROJ};
                    attn_unit<1>(C, S, qb, btab + (4 + h) * 320, nullptr, O + rb * DM + 1 * 256 + h * 64, 0.f, 0.f, nullptr, 0.f); } }
            if (up == vcu && s8 == conv_at) { ph_conv_experts(A, C, l); __syncthreads(); }
        } }
}

struct MergeSched : pg8::PlainRows { const char* hb; const char* O; const char* Wg; const char* Wb; int G, c;
    __device__ __forceinline__ bool next(int i, pg8::Unit& u) const { int reg = c + G * (i >> 3); if (reg >= (NT / 256) * 4) return false;
        if ((G & 31) == 0) { const int x = c & 7, j = c >> 3, per = G >> 5; reg = ((i >> 3) * (G >> 2) + x * per + (j >> 2)) * 4 + (j & 3); }
        const int sq = i & 7, pm = reg >> 2, pc = reg & 3; u.pm = pm; u.pn = pc; u.aux = sq;
        if (sq < 4) { u.A = O + (size_t)pm * 256 * 2048 + sq * 512; u.B = Wb + (size_t)pc * 256 * 2048 + sq * 512; u.nt = 4; }
        else { u.A = hb + (size_t)pm * 256 * 2048; u.B = Wg + (size_t)((pc * 4 + (sq - 4)) * 256) * 2048; u.nt = 16; }
        return true; } };
struct EpiMerge { unsigned char* park; const float* bg; bf16* mg;
    __device__ __forceinline__ void operator()(const f32x4 (&acc)[2][2][4][2], const pg8::Unit& u, int tid, int wr, int wc, int fr, int fq) const {
        const __amdgpu_buffer_rsrc_t rs = __builtin_amdgcn_make_buffer_rsrc(park, 0, 512 * 1024, 0x00020000);
        if (u.aux < 4) { const int vo = ((wr * 64 + fr) * 256 + wc * 32 + 8 * fq) * 2, so = u.aux * 131072;
#pragma unroll
            for (int ai = 0; ai < 2; ++ai)
#pragma unroll
                for (int m = 0; m < 4; ++m)
#pragma unroll
                    for (int bj = 0; bj < 2; ++bj) __builtin_amdgcn_raw_buffer_store_b128(pack8(acc[ai][bj][m][0], acc[ai][bj][m][1]), rs, vo, so + (ai * 128 + m * 16) * 512 + bj * 256, 0);
        } else { const int cq = u.aux - 4; const int vo = ((wr * 64 + fr) * 256 + wc * 16 + fq * 4) * 2, so = cq * 128; const int c4 = u.pn * 256 + cq * 64 + wc * 16 + fq * 4;
            f32x4 bias[4];
#pragma unroll
            for (int n = 0; n < 4; ++n) bias[n] = *(const f32x4*)(bg + n * DM + c4);
#pragma unroll
            for (int ai = 0; ai < 2; ++ai) {
                u32x2 ub[4][4];
#pragma unroll
                for (int m = 0; m < 4; ++m)
#pragma unroll
                    for (int n = 0; n < 4; ++n) ub[m][n] = __builtin_amdgcn_raw_buffer_load_b64(rs, vo, so + n * 131072 + (ai * 128 + m * 16) * 512, 16);
#pragma unroll
                for (int m = 0; m < 4; ++m) { f32x4 t = {0.f, 0.f, 0.f, 0.f};
#pragma unroll
                    for (int n = 0; n < 4; ++n) { f32x4 g = acc[ai][n >> 1][m][n & 1] + bias[n]; const u32x2 uw = ub[m][n];
#pragma unroll
                        for (int i = 0; i < 4; ++i) g[i] = __builtin_amdgcn_rcpf(1.f + __builtin_amdgcn_exp2f(-LOG2E * g[i]));
                        t += g * (f32x4){bflo(uw.x), bfhi(uw.x), bflo(uw.y), bfhi(uw.y)}; }
                    u32x2 w; w.x = cvtpk(t[0], t[1]); w.y = cvtpk(t[2], t[3]);
                    *(u32x2*)(mg + (size_t)(u.pm * 256 + ai * 128 + wr * 64 + m * 16 + fr) * DM + c4) = w; } } } }
};
__device__ __forceinline__ void ph_merge(const Args& A, const Ctx& C0, int l) { const Ctx C = fresh(C0);
    MergeSched S; S.hb = (const char*)WSP(bf16, WS_HB); S.O = (const char*)WSP(bf16, WS_R3); S.Wg = (const char*)WSP(bf16, WS_WSM + l * WSM_STRIDE + WO_WG); S.Wb = (const char*)WSP(bf16, WS_WSM + l * WSM_STRIDE + WO_WB); S.G = C.G; S.c = blockIdx.x;
    unsigned char* park = C.ws + WS_R1 + (size_t)blockIdx.x * (512 * 1024);
    EpiMerge E{park, A.in[14] + (size_t)l * 4 * DM, WSP(bf16, WS_R2)};
    pg8::gemm_phase<false>(C.lds, C.tid, DM * 2, DM * 2, S, E);
}

__device__ __forceinline__ void ph_out(const Ctx& C0, int l) { const Ctx C = fresh(C0);
    GridSched S; S.A = (const char*)WSP(bf16, WS_R2); S.B = (const char*)WSP(bf16, WS_WSM + l * WSM_STRIDE + WO_WO); S.nM = NT / 256; S.nN = DM / 256; S.nt = DM / 64; S.G = C.G; S.c = blockIdx.x; S.lda = DM * 2; S.ldb = DM * 2;
    EpiStoreBf16 E{WSP(bf16, WS_R1), DM};
    pg8::gemm_phase<false>(C.lds, C.tid, DM * 2, DM * 2, S, E);
}

__device__ __forceinline__ void ph_ln1_route(const Args& A, const Ctx& C0, int l, bool dry = false) { const Ctx C = fresh(C0);
    const bf16* y1 = WSP(bf16, WS_R1); bf16* hb = WSP(bf16, WS_HB); bf16* hbo = dry ? WSP(bf16, WS_R3) : hb;
    const float* g = A.in[17] + l * DM; const float* bb = A.in[18] + l * DM;
    const float* wrt = WSP(float, WS_MISC + MO_WRT) + (size_t)l * 36 * DM; const float* bgr = A.in[20] + l * 4; const float* be = A.in[22] + l * 32;
    float* gatev = WSP(float, WS_MISC + MO_GATE); int* list = WSP(int, WS_MISC + MO_LIST); unsigned* cnt = WSP(unsigned, WS_CTL) + CW_CNT + l * 32;
    LAS float* wel = (LAS float*)C.lds;
    LAS unsigned* lcnt = (LAS unsigned*)(C.lds + LDS_TAB); LAS unsigned* lbase = lcnt + 32;
    __syncthreads();
    for (int i = C.tid; i < 32 * DM / 4; i += NTHR) ((LAS f32x4*)wel)[i] = ((const f32x4*)(wrt + 4 * DM))[i];
    f32x4 wgr[4][4];
#pragma unroll
    for (int e = 0; e < 4; ++e)
#pragma unroll
        for (int j = 0; j < 4; ++j) wgr[e][j] = *(const f32x4*)(wrt + e * DM + 8 * C.lane + 512 * (j >> 1) + 4 * (j & 1));
    for (int blk = blockIdx.x; blk < NT / 128; blk += C.G) {
        if (C.tid < 32) lcnt[C.tid] = 0u;
        __syncthreads();
        int my_ea = 0, my_eb = 0; float my_ga = 0.f, my_gb = 0.f;
        f32x4 vn[4];
#pragma unroll
        for (int j = 0; j < 2; ++j) { const size_t o = (size_t)(blk * 128 + C.wave * 16) * DM + 8 * C.lane + 512 * j; f32x4 h0, h1, y0, y1v; ld8bf(hb + o, h0, h1); ld8bf(y1 + o, y0, y1v); vn[2 * j] = h0 * DN_ALPHA + y0; vn[2 * j + 1] = h1 * DN_ALPHA + y1v; }
        for (int r = 0; r < 16; ++r) { const int m = blk * 128 + C.wave * 16 + r; f32x4 v[4];
#pragma unroll
            for (int j = 0; j < 4; ++j) v[j] = vn[j];
            if (r + 1 < 16) {
#pragma unroll
                for (int j = 0; j < 2; ++j) { const size_t o = (size_t)(m + 1) * DM + 8 * C.lane + 512 * j; f32x4 h0, h1, y0, y1v; ld8bf(hb + o, h0, h1); ld8bf(y1 + o, y0, y1v); vn[2 * j] = h0 * DN_ALPHA + y0; vn[2 * j + 1] = h1 * DN_ALPHA + y1v; } }
            ln_row(v, g, bb, nullptr, hbo + (size_t)m * DM, C.lane);
            float gg[4];
#pragma unroll
            for (int e = 0; e < 4; ++e) { float p = 0.f;
#pragma unroll
                for (int j = 0; j < 4; ++j) p += (v[j].x * wgr[e][j].x + v[j].y * wgr[e][j].y) + (v[j].z * wgr[e][j].z + v[j].w * wgr[e][j].w);
                gg[e] = wave_sum_l(p, C.lane) + bgr[e]; }
            int gi = 0; float gm = gg[0];
#pragma unroll
            for (int i = 1; i < 4; ++i) if (gg[i] > gm) { gm = gg[i]; gi = i; }
            float gs = 0.f;
#pragma unroll
            for (int i = 0; i < 4; ++i) gs += expf(gg[i] - gm);
            const float g_val = 1.f / gs;
            gi = __builtin_amdgcn_readfirstlane(gi);
            float el[8];
#pragma unroll
            for (int e = 0; e < 8; ++e) { const LAS float* wr = wel + (gi * 8 + e) * DM + 8 * C.lane; float p = 0.f;
#pragma unroll
                for (int j = 0; j < 4; ++j) { const f32x4 w = *(const LAS f32x4*)(wr + 512 * (j >> 1) + 4 * (j & 1)); p += (v[j].x * w.x + v[j].y * w.y) + (v[j].z * w.z + v[j].w * w.w); }
                el[e] = wave_sum_l(p, C.lane) + be[gi * 8 + e]; }
            int i1 = 0; float m1 = el[0];
#pragma unroll
            for (int i = 1; i < 8; ++i) if (el[i] > m1) { m1 = el[i]; i1 = i; }
            int i2 = -1; float m2 = -1e30f;
#pragma unroll
            for (int i = 0; i < 8; ++i) if (i != i1 && el[i] > m2) { m2 = el[i]; i2 = i; }
            const float p2 = expf(m2 - m1); const float ga = g_val / (1.f + p2), gb = g_val * p2 / (1.f + p2);
            if (C.lane == r) { my_ea = gi * 8 + i1; my_eb = gi * 8 + i2; my_ga = ga; my_gb = gb; } }
        unsigned ia = 0u, ib = 0u;
        if (dry) continue;
        if (C.lane < 16) { ia = __hip_atomic_fetch_add(lcnt + my_ea, 1u, __ATOMIC_RELAXED, __HIP_MEMORY_SCOPE_WORKGROUP); ib = __hip_atomic_fetch_add(lcnt + my_eb, 1u, __ATOMIC_RELAXED, __HIP_MEMORY_SCOPE_WORKGROUP); }
        __syncthreads();
        if (C.tid < 32) lbase[C.tid] = atomicAdd(cnt + C.tid, lcnt[C.tid]);
        __syncthreads();
        if (C.lane < 16) { const int m = blk * 128 + C.wave * 16 + C.lane;
            gatev[2 * m] = my_ga; gatev[2 * m + 1] = my_gb;
            list[(size_t)my_ea * NSLOT + lbase[my_ea] + ia] = 2 * m; list[(size_t)my_eb * NSLOT + lbase[my_eb] + ib] = 2 * m + 1; }
        __syncthreads();
    }
}

__device__ __forceinline__ void moe_tables(const Ctx& C, int l, LAS int* tb, LAS int* cn) {
    const unsigned* cnt = WSP(unsigned, WS_CTL) + CW_CNT + l * 32;
    __syncthreads();
    if (C.tid == 0) { int t = 0; for (int e = 0; e < NEXP; ++e) { const int c = (int)__hip_atomic_load(cnt + e, __ATOMIC_RELAXED, __HIP_MEMORY_SCOPE_AGENT); cn[e] = c; tb[e] = t; t += (c + 255) / 256; } tb[NEXP] = t; }
    __syncthreads();
}
struct MoeSched { const char* hb; const char* hbuf; const char* wexp; const int* list; LAS int* tb; LAS int* cn; int G, c, up;
    __device__ __forceinline__ bool next(int i, pg8::Unit& u) const { const int cx = (G & 7) == 0 ? (c & 7) * (G >> 3) + (c >> 3) : c;
        const int L = i * G + cx; if (L >= tb[NEXP] * 4) return false;
        const int tg = L >> 2, pn = L & 3; int e = 0; while (tb[e + 1] <= tg) ++e;
        u.pm = tg; u.pn = pn; u.aux = e | ((tg - tb[e]) << 8);
        if (up) { u.A = hb; u.B = wexp + (size_t)e * 3 * DM * DEXP * 2 + (size_t)pn * 256 * 2048; u.nt = 16; }
        else { u.A = hbuf + (size_t)tg * 256 * (DEXP * 2); u.B = wexp + (size_t)e * 3 * DM * DEXP * 2 + (size_t)2 * DM * DEXP * 2 + (size_t)pn * 256 * (DEXP * 2); u.nt = 8; }
        return true; }
    __device__ __forceinline__ void a_rows(const pg8::Unit& u, const int (&RA)[2], const int (&CA2)[2], int lda, unsigned (&va)[2][2]) const {
        const int e = u.aux & 255, ti = u.aux >> 8, c_e = cn[e];
#pragma unroll
        for (int h = 0; h < 2; ++h)
#pragma unroll
            for (int i = 0; i < 2; ++i) { const int r = h * 128 + RA[i];
                if (up) { const int rr = ti * 256 + r; const int tok = rr < c_e ? (list[(size_t)e * NSLOT + rr] >> 1) : 0; va[h][i] = (unsigned)tok * 2048u + (unsigned)CA2[i]; }
                else va[h][i] = (unsigned)(r * lda + CA2[i]); } }
};
struct EpiExpUp { bf16* hbuf;
    __device__ __forceinline__ void operator()(const f32x4 (&acc)[2][2][4][2], const pg8::Unit& u, int tid, int wr, int wc, int fr, int fq) const {
        const int row0 = u.pm * 256 + wr * 64 + fr, col0 = u.pn * 128 + wc * 32 + 8 * fq;
#pragma unroll
        for (int ai = 0; ai < 2; ++ai)
#pragma unroll
            for (int m = 0; m < 4; ++m) { f32x4 h0, h1;
#pragma unroll
                for (int i = 0; i < 4; ++i) { const float a0 = acc[ai][0][m][0][i], a1 = acc[ai][0][m][1][i];
                    h0[i] = a0 * __builtin_amdgcn_rcpf(1.f + __builtin_amdgcn_exp2f(-LOG2E * a0)) * acc[ai][1][m][0][i]; h1[i] = a1 * __builtin_amdgcn_rcpf(1.f + __builtin_amdgcn_exp2f(-LOG2E * a1)) * acc[ai][1][m][1][i]; }
                *(u32x4*)(hbuf + (size_t)(row0 + ai * 128 + m * 16) * DEXP + col0) = pack8(h0, h1); } }
};
struct EpiExpDown { bf16* ys; const int* list; const float* gatev; int* inv; LAS int* cn;
    __device__ __forceinline__ void operator()(const f32x4 (&acc)[2][2][4][2], const pg8::Unit& u, int tid, int wr, int wc, int fr, int fq) const {
        const int e = u.aux & 255, ti = u.aux >> 8, c_e = cn[e]; const int col0 = u.pn * 256 + wc * 32 + 8 * fq;
#pragma unroll
        for (int ai = 0; ai < 2; ++ai)
#pragma unroll
            for (int m = 0; m < 4; ++m) { const int rl = ai * 128 + wr * 64 + m * 16 + fr, rr = ti * 256 + rl;
                if (rr < c_e) { const int slot = list[(size_t)e * NSLOT + rr]; const float g = gatev[slot]; const size_t dest = (size_t)u.pm * 256 + rl;
#pragma unroll
                    for (int bj = 0; bj < 2; ++bj) *(u32x4*)(ys + dest * DM + col0 + bj * 128) = pack8(acc[ai][bj][m][0] * g, acc[ai][bj][m][1] * g);
                    if (u.pn == 0 && wc == 0 && fq == 0) inv[slot] = (int)dest; } } }
};
__device__ __forceinline__ void ph_exp_up(const Ctx& C0, int l) { const Ctx C = fresh(C0);
    LAS int* tb = (LAS int*)(C.lds + LDS_TAB); LAS int* cn = tb + 64;
    moe_tables(C, l, tb, cn);
    MoeSched S; S.hb = (const char*)WSP(bf16, WS_HB); S.hbuf = (const char*)WSP(bf16, WS_R3); S.wexp = (const char*)WSP(bf16, WS_WEXP); S.list = WSP(int, WS_MISC + MO_LIST); S.tb = tb; S.cn = cn; S.G = C.G; S.c = blockIdx.x; S.up = 1;
    EpiExpUp E{WSP(bf16, WS_R3)};
    pg8::gemm_phase<true>(C.lds, C.tid, DM * 2, DM * 2, S, E);
}
__device__ __forceinline__ void ph_exp_down(const Ctx& C0, int l) { const Ctx C = fresh(C0);
    LAS int* tb = (LAS int*)(C.lds + LDS_TAB); LAS int* cn = tb + 64;
    moe_tables(C, l, tb, cn);
    MoeSched S; S.hb = (const char*)WSP(bf16, WS_HB); S.hbuf = (const char*)WSP(bf16, WS_R3); S.wexp = (const char*)WSP(bf16, WS_WEXP); S.list = WSP(int, WS_MISC + MO_LIST); S.tb = tb; S.cn = cn; S.G = C.G; S.c = blockIdx.x; S.up = 0;
    EpiExpDown E{WSP(bf16, WS_R1), WSP(int, WS_MISC + MO_LIST), WSP(float, WS_MISC + MO_GATE), WSP(int, WS_MISC + MO_INV), cn};
    pg8::gemm_phase<false>(C.lds, C.tid, DEXP * 2, DEXP * 2, S, E);
}
__device__ __forceinline__ void ph_combine(const Args& A, const Ctx& C0, int l, bool dry = false) { const Ctx C = fresh(C0);
    const int* inv = WSP(int, WS_MISC + MO_INV); const bf16* ys = WSP(bf16, WS_R1); bf16* hb = WSP(bf16, WS_HB); bf16* hbo = dry ? WSP(bf16, WS_R3) : hb;
    const float* g = A.in[26] + l * DM; const float* bb = A.in[27] + l * DM;
    for (int m = 2 * C.gw; m < NT; m += 2 * C.ngw) {
        const int4 iv = *(const int4*)(inv + 2 * m); f32x4 v[2][4];
#pragma unroll
        for (int r = 0; r < 2; ++r) { const size_t d0 = (size_t)(r ? iv.z : iv.x), d1 = (size_t)(r ? iv.w : iv.y);
#pragma unroll
            for (int j = 0; j < 2; ++j) { const int c = 8 * C.lane + 512 * j; f32x4 h0, h1, a0, a1, b0, b1;
                ld8bf(hb + (size_t)(m + r) * DM + c, h0, h1); ld8bf(ys + d0 * DM + c, a0, a1); ld8bf(ys + d1 * DM + c, b0, b1);
                v[r][2 * j] = h0 * DN_ALPHA + a0 + b0; v[r][2 * j + 1] = h1 * DN_ALPHA + a1 + b1; } }
#pragma unroll
        for (int r = 0; r < 2; ++r) ln_row(v[r], g, bb, (l == NL - 1 && !dry) ? C.hf + (size_t)(m + r) * DM : nullptr, hbo + (size_t)(m + r) * DM, C.lane); }
}

__global__ void __launch_bounds__(NTHR, 2) fwd(Args args) {
    extern __shared__ __attribute__((aligned(16))) unsigned char lds_raw[];
    Ctx C;
    C.hf = args.out; C.ws = args.ws; C.lds = (LAS unsigned char*)lds_raw;
    C.tid = threadIdx.x; C.lane = C.tid & 63; C.wave = __builtin_amdgcn_readfirstlane(C.tid >> 6); C.G = gridDim.x;
    C.gw = blockIdx.x * NWAVES + C.wave; C.ngw = C.G * NWAVES;
    for (int u = C.tid; u < (LDS_BYTES - LDS_MISC) / 4; u += NTHR) ((LAS unsigned*)(C.lds + LDS_MISC))[u] = 0u;
    __syncthreads();
    XcdBarrier bar = xcd_barrier_post(WSP(unsigned, WS_CTL) + CW_BAR, (volatile LAS unsigned*)(C.lds + LDS_MISC), (unsigned)C.wave);
#define GRID_BAR() do { XcdBarrier b_ = bar; asm volatile("" : "+s"(b_.bar), "+s"(b_.x), "+s"(b_.wv)); xcd_barrier(b_); } while (0)
#define RUNPH(k, call) do { call; GRID_BAR(); if (PROBE_DUP == (k)) { call; GRID_BAR(); } } while (0)
    ph_prologue(args, C); GRID_BAR(); if (PROBE_DUP == 0) { ph_prologue(args, C); GRID_BAR(); }
    for (int l = 0; l < NL; ++l) {
        RUNPH(1, ph_proj(args, C, l));
        RUNPH(3, ph_mla_up(args, C, l));
        RUNPH(4, ph_attn(args, C, l));
        RUNPH(5, ph_merge(args, C, l));
        RUNPH(6, ph_out(C, l));
        if (PROBE_DUP == 10) { ph_ln1_route(args, C, l, true); GRID_BAR(); }
        ph_ln1_route(args, C, l); GRID_BAR();
        RUNPH(8, ph_exp_up(C, l));
        RUNPH(9, ph_exp_down(C, l));
        if (PROBE_DUP == 11) { ph_combine(args, C, l, true); GRID_BAR(); }
        ph_combine(args, C, l); if (l + 1 < NL) GRID_BAR();
    }
}

extern "C" void kernel_launch(void* const* d_in, const int* in_sizes, int n_in, void* d_out, int out_size, void* d_ws, size_t ws_size, hipStream_t stream) {
    static int grid = 0;
    if (grid == 0) {
        if (n_in != 28 || out_size != NT * DM || ws_size < WS_END) { fprintf(stderr, "kernel_launch: unexpected shapes (n_in %d out %d ws %zu)\n", n_in, out_size, ws_size); grid = -1; return; }
        int dev = 0, cus = 0, per_cu = 0;
        if (hipGetDevice(&dev) != hipSuccess || hipDeviceGetAttribute(&cus, hipDeviceAttributeMultiprocessorCount, dev) != hipSuccess) { grid = -1; return; }
        if (hipFuncSetAttribute((const void*)fwd, hipFuncAttributeMaxDynamicSharedMemorySize, LDS_BYTES) != hipSuccess) { grid = -1; return; }
        if (hipOccupancyMaxActiveBlocksPerMultiprocessor(&per_cu, (const void*)fwd, NTHR, LDS_BYTES) != hipSuccess || per_cu < 1) { fprintf(stderr, "kernel_launch: occupancy query says %d blocks per CU\n", per_cu); (void)hipGetLastError(); grid = -1; return; }
        grid = cus;
    }
    if (grid < 0) return;
    (void)hipMemsetAsync((char*)d_ws + WS_CTL, 0, CTL_BYTES, stream);
    Args a{};
    for (int i = 0; i < 28; ++i) a.in[i] = (const float*)d_in[i];
    a.out = (float*)d_out; a.ws = (unsigned char*)d_ws; a.ph_lo = 0; a.ph_hi = 0;
    hipLaunchKernelGGL(fwd, dim3(grid), dim3(NTHR), LDS_BYTES, stream, a);
}
```

```cpp
#include <hip/hip_runtime.h>
#include <cstdio>
#include <cstdint>
#ifndef PROBE_DUP
#define PROBE_DUP -1
#endif

#define GAS __attribute__((address_space(1)))
#define LAS __attribute__((address_space(3)))
typedef unsigned short bf16;
typedef short bf16x8 __attribute__((ext_vector_type(8)));
typedef float f32x4 __attribute__((ext_vector_type(4)));
typedef float f32x16 __attribute__((ext_vector_type(16)));
typedef unsigned u32x4 __attribute__((ext_vector_type(4)));
typedef unsigned u32x2 __attribute__((ext_vector_type(2)));

constexpr int NB = 4, SEQ = 8192, DM = 1024, NT = NB * SEQ, NL = 2;
constexpr int DIN = 2724, NPROJ = 2816;
constexpr int PC_DQ = 0, PC_DK = 256, PC_DV = 512, PC_BQ = 768, PC_BK = 1024, PC_BV = 1280, PC_CQ = 1536, PC_FQ = 1792, PC_FK = 2048, PC_FV = 2304,
              PC_CKV = 2560, PC_KR = 2688, PC_FF = 2720;
constexpr float LOG2E = 1.4426950408889634f;
constexpr float SC32 = 0.17677669529663687f * LOG2E, SC64 = 0.125f * LOG2E, SC96 = 0.10206207261596575f * LOG2E;
constexpr float LN_EPS = 1e-5f;
constexpr float DN_ALPHA = 1.4142135623730951f;
constexpr int NEXP = 32, DEXP = 512, NSLOT = NT * 2, MAXROWS = NSLOT + NEXP * 256;

constexpr size_t MiB = 1u << 20;
constexpr size_t WS_CTL = 0, CTL_BYTES = 1 * MiB;
constexpr size_t WS_WSM = 1 * MiB, WSM_STRIDE = 20 * MiB;
constexpr size_t WO_WIN = 0, WO_WG = 6 * MiB, WO_WB = 14 * MiB, WO_WO = 16 * MiB, WO_WUQ = 18 * MiB, WO_WUKV = 18 * MiB + 512 * 1024;
constexpr size_t WS_MISC = 41 * MiB;
constexpr size_t MO_ROPE = 0, MO_T5 = 1 * MiB, MO_RSTD = 1 * MiB + 64 * 1024, MO_WRT = 1 * MiB + 384 * 1024  , MO_SUM64 = 1 * MiB + 768 * 1024  , MO_CUM = 2 * MiB, MO_EID = 3 * MiB, MO_GATE = 3 * MiB + 512 * 1024, MO_INV = 4 * MiB, MO_LIST = 5 * MiB;
constexpr size_t WS_WEXP = 56 * MiB;
constexpr size_t WS_HB = 152 * MiB;
constexpr size_t WS_R1 = 216 * MiB;
constexpr size_t WS_R2 = 392 * MiB;
constexpr size_t WS_R3 = 456 * MiB;
constexpr size_t WS_END = 528 * MiB;
constexpr int CW_CNT = 1024, CW_QKMAX = 2048  , CW_BAR = 4096;

constexpr int NWAVES = 8, NTHR = 512;
constexpr int LDS_BYTES = 147456, LDS_TAB = 131072, LDS_MISC = 131072 + 4096;

struct Args { const float* in[28]; float* out; unsigned char* ws; int ph_lo, ph_hi; };

__device__ __forceinline__ unsigned f2bf(float f) { unsigned u = __builtin_bit_cast(unsigned, f); return (u + 0x7fffu + ((u >> 16) & 1u)) >> 16; }
__device__ __forceinline__ unsigned pk2(float lo, float hi) { return f2bf(lo) | (f2bf(hi) << 16); }
__device__ __forceinline__ float bflo(unsigned w) { return __builtin_bit_cast(float, w << 16); }
__device__ __forceinline__ float bfhi(unsigned w) { return __builtin_bit_cast(float, w & 0xffff0000u); }
__device__ __forceinline__ float bf2f(bf16 b) { return __builtin_bit_cast(float, (unsigned)b << 16); }
__device__ __forceinline__ int crow(int r, int hi) { return (r & 3) + 8 * (r >> 2) + 4 * hi; }
__device__ __forceinline__ int lane_id_asm() { int l; asm volatile("v_mbcnt_lo_u32_b32 %0, -1, 0\n\tv_mbcnt_hi_u32_b32 %0, -1, %0" : "=v"(l)); return l; }
__device__ __forceinline__ float shfl_xor_l(float v, int o, int lane) { return __builtin_bit_cast(float, __builtin_amdgcn_ds_bpermute((lane ^ o) << 2, __builtin_bit_cast(int, v))); }
__device__ __forceinline__ float shfl_up_l(float v, int o, int lane) { return __builtin_bit_cast(float, __builtin_amdgcn_ds_bpermute((lane - o) << 2, __builtin_bit_cast(int, v))); }
__device__ __forceinline__ float wave_sum_l(float v, int) {
    v += __builtin_bit_cast(float, __builtin_amdgcn_update_dpp(0, __builtin_bit_cast(int, v), 0x111, 0xf, 0xf, true));
    v += __builtin_bit_cast(float, __builtin_amdgcn_update_dpp(0, __builtin_bit_cast(int, v), 0x112, 0xf, 0xf, true));
    v += __builtin_bit_cast(float, __builtin_amdgcn_update_dpp(0, __builtin_bit_cast(int, v), 0x114, 0xf, 0xf, true));
    v += __builtin_bit_cast(float, __builtin_amdgcn_update_dpp(0, __builtin_bit_cast(int, v), 0x118, 0xf, 0xf, true));
    v += __builtin_bit_cast(float, __builtin_amdgcn_update_dpp(0, __builtin_bit_cast(int, v), 0x142, 0xa, 0xf, false));
    v += __builtin_bit_cast(float, __builtin_amdgcn_update_dpp(0, __builtin_bit_cast(int, v), 0x143, 0xc, 0xf, false));
    return __builtin_bit_cast(float, __builtin_amdgcn_readlane(__builtin_bit_cast(int, v), 63));
}
__device__ __forceinline__ unsigned cvtpk(float lo, float hi) { unsigned r; asm("v_cvt_pk_bf16_f32 %0, %1, %2" : "=v"(r) : "v"(lo), "v"(hi)); return r; }
__device__ __forceinline__ unsigned cvtpk_dep(float lo, float hi, float dep) { unsigned r; asm("v_cvt_pk_bf16_f32 %0, %1, %2" : "=v"(r) : "v"(lo), "v"(hi), "v"(dep)); return r; }
__device__ __forceinline__ void glds16(const void* gbase, unsigned voff, unsigned lds_dst) { unsigned keep;
    asm volatile("s_mov_b32 %0, m0\n\ts_mov_b32 m0, %3\n\ts_nop 0\n\tglobal_load_lds_dwordx4 %1, %2\n\ts_mov_b32 m0, %0" : "=&s"(keep) : "v"(voff), "s"(gbase), "s"(lds_dst) : "memory"); }
#define MFMA32(a, b, c) __builtin_amdgcn_mfma_f32_32x32x16_bf16(a, b, c, 0, 0, 0)

template <int N> __device__ __forceinline__ void wave_gemm(const bf16* arow, const bf16* const (&brow)[N], int K, int hi, f32x16 (&acc)[N]) {
#pragma unroll 4
    for (int k = 0; k < K; k += 16) {
        const bf16x8 a = *(const bf16x8*)(arow + k + 8 * hi);
#pragma unroll
        for (int n = 0; n < N; ++n) { const bf16x8 b = *(const bf16x8*)(brow[n] + k + 8 * hi); acc[n] = MFMA32(a, b, acc[n]); }
    }
}

constexpr int CONV_SCR = 16896;
template <class F> __device__ __forceinline__ void transpose_item(const F& f, bf16* WT, int ldk, int n0, int k0, LAS float* scr, int lane) {
#pragma unroll
    for (int kk = 0; kk < 64; ++kk) scr[kk * 65 + lane] = f(k0 + kk, n0 + lane);
    asm volatile("s_waitcnt lgkmcnt(0)" ::: "memory");
    const int c = lane & 7;
#pragma unroll
    for (int j = 0; j < 8; ++j) { const int n = (lane >> 3) + 8 * j; const LAS float* s = scr + (8 * c) * 65 + n;
        u32x4 o; o.x = pk2(s[0 * 65], s[1 * 65]); o.y = pk2(s[2 * 65], s[3 * 65]); o.z = pk2(s[4 * 65], s[5 * 65]); o.w = pk2(s[6 * 65], s[7 * 65]);
        *(u32x4*)(WT + (size_t)(n0 + n) * ldk + k0 + 8 * c) = o; }
    asm volatile("s_waitcnt lgkmcnt(0)" ::: "memory");
}
template <class F> __device__ __forceinline__ void conv_matrix(const F& f, bf16* WT, int nrows, int kcols, LAS float* scr, int lane, int gw, int ngw, int& base) {
    const int nkb = kcols / 64, items = (nrows / 64) * nkb; int first = (gw - base) % ngw; if (first < 0) first += ngw;
    for (int it = first; it < items; it += ngw) transpose_item(f, WT, kcols, (it / nkb) * 64, (it % nkb) * 64, scr, lane);
    base += items;
}

__device__ __forceinline__ void sincos_acc(float ang, float& s, float& c) {
    const double x = (double)ang; const double kq = __builtin_rint(x * 0.63661977236758134308);
    double r = __builtin_fma(-kq, 1.57079632679489655800e+00, x); r = __builtin_fma(-kq, 6.12323399573676603587e-17, r);
    const double r2 = r * r;
    double sp = r * (1.0 + r2 * (-1.0 / 6 + r2 * (1.0 / 120 + r2 * (-1.0 / 5040 + r2 * (1.0 / 362880 + r2 * (-1.0 / 39916800 + r2 * (1.0 / 6227020800.0)))))));
    double cp = 1.0 + r2 * (-0.5 + r2 * (1.0 / 24 + r2 * (-1.0 / 720 + r2 * (1.0 / 40320 + r2 * (-1.0 / 3628800 + r2 * (1.0 / 479001600.0))))));
    const int q = ((int)kq) & 3;
    double ss = (q & 1) ? cp : sp, cc = (q & 1) ? sp : cp;
    if (q == 1) cc = -cc; else if (q == 2) { ss = -ss; cc = -cc; } else if (q == 3) ss = -ss;
    s = (float)ss; c = (float)cc;
}


namespace pg8 {
constexpr int BM = 256, BK = 64, HALF = 128, HTB = HALF * BK * 2, STAGE_BYTES = 8 * HTB;
__device__ __forceinline__ int lds_byte(int r, int c) { const int st = (r >> 4) * 2 + (c >> 5), rr = r & 15, cc = c & 31, ob = rr * 64 + cc * 2; return st * 1024 + (ob ^ (((ob >> 9) & 1) << 5)); }
__device__ __forceinline__ void stage_rc(int b, int& R, int& Cc) { const int st = b / 1024, sb = b % 1024, swz = sb ^ (((sb >> 9) & 1) << 5); R = (st >> 1) * 16 + swz / 64; Cc = (st & 1) * 32 + (swz % 64) / 2; }
__device__ __forceinline__ int perm32(int rho) { const int n = rho >> 4, i = rho & 15; return 8 * (i >> 2) + 4 * n + (i & 3); }
struct Unit { int pm, pn, nt, aux; const char* A; const char* B; };
template <bool GATHER, class Epi, class Sched> __device__ __forceinline__ void gemm_phase(LAS unsigned char* lds, const int tid_in, const int lda, const int ldb, const Sched& S, const Epi& E) {
    int tid_ = tid_in; asm volatile("" : "+v"(tid_));
    const int tid = tid_, wid = __builtin_amdgcn_readfirstlane(tid >> 6), lane = tid & 63, wr = wid >> 2, wc = wid & 3, fr = lane & 15, fq = lane >> 4;
    int RA[2], CA2[2]; unsigned voffB[2];
#pragma unroll
    for (int i = 0; i < 2; ++i) { int R, Cc; stage_rc(tid * 16 + i * 8192, R, Cc); RA[i] = R; CA2[i] = Cc * 2; const int Rb = (R & ~31) + perm32(R & 31); voffB[i] = (unsigned)(Rb * ldb + Cc * 2); }
    const size_t kstep = (size_t)(BK * 2); const size_t hstepB = (size_t)HALF * ldb;
    const unsigned ldsb = (unsigned)(uintptr_t)lds + (unsigned)wid * 1024u;
    const int aoff = lds_byte(wr * 64 + fr, fq * 8), boff = lds_byte(wc * 32 + fr, fq * 8);
#define PG8_SA(b, h) (((b) * 2 + (h)) * HTB)
#define PG8_SB(b, h) ((4 + (b) * 2 + (h)) * HTB)
#define PG8_STAGE(bufoff, gbase, voff) do { _Pragma("unroll") for (int _i = 0; _i < 2; ++_i) \
        glds16((const char*)(gbase), (voff)[_i], (unsigned)__builtin_amdgcn_readfirstlane(ldsb + (unsigned)((bufoff) + _i * 8192))); } while (0)
#define PG8_LDA(dst, b, h) do { _Pragma("unroll") for (int m = 0; m < 4; ++m) _Pragma("unroll") for (int k = 0; k < 2; ++k) dst[m][k] = *(const LAS bf16x8*)(lds + PG8_SA(b, h) + aoff + m * 2048 + k * 1024); } while (0)
#define PG8_LDB(dst, b, h) do { _Pragma("unroll") for (int n = 0; n < 2; ++n) _Pragma("unroll") for (int k = 0; k < 2; ++k) dst[n][k] = *(const LAS bf16x8*)(lds + PG8_SB(b, h) + boff + n * 2048 + k * 1024); } while (0)
#define PG8_MMA(ai, bj, At, Bt) do { __builtin_amdgcn_s_setprio(1); _Pragma("unroll") for (int m = 0; m < 4; ++m) _Pragma("unroll") for (int n = 0; n < 2; ++n) _Pragma("unroll") for (int k = 0; k < 2; ++k) \
        acc[ai][bj][m][n] = __builtin_amdgcn_mfma_f32_16x16x32_bf16(Bt[n][k], At[m][k], acc[ai][bj][m][n], 0, 0, 0); __builtin_amdgcn_s_setprio(0); } while (0)
#define PG8_WAIT_V(n) asm volatile("s_waitcnt vmcnt(" #n ")" ::: "memory")
#define PG8_WAIT_L(n) asm volatile("s_waitcnt lgkmcnt(" #n ")" ::: "memory")
#define PG8_BAR __builtin_amdgcn_s_barrier()
#define PG8_SCHED __builtin_amdgcn_sched_barrier(0)
    Unit cur, nxt; int ui = 0;
    if (!S.next(0, cur)) return;
    f32x4 acc[2][2][4][2];
#pragma unroll
    for (int a = 0; a < 2; ++a)
#pragma unroll
        for (int b = 0; b < 2; ++b)
#pragma unroll
            for (int m = 0; m < 4; ++m)
#pragma unroll
                for (int n = 0; n < 2; ++n) acc[a][b][m][n] = (f32x4){0.f, 0.f, 0.f, 0.f};
    bf16x8 At[4][2], B0[2][2], B1[2][2];
    unsigned va[2][2], nva[2][2];
    S.a_rows(cur, RA, CA2, lda, va);
    const char* cA = cur.A; const char* cB = cur.B;
    PG8_STAGE(PG8_SB(0, 0), cB, voffB); PG8_STAGE(PG8_SB(0, 1), cB + hstepB, voffB); PG8_STAGE(PG8_SA(0, 0), cA, va[0]); PG8_STAGE(PG8_SA(0, 1), cA, va[1]);
    if (wr == 1) PG8_BAR;
    PG8_WAIT_V(2); PG8_BAR;
    PG8_STAGE(PG8_SB(1, 0), cB + kstep, voffB); PG8_STAGE(PG8_SA(1, 0), cA + kstep, va[0]); PG8_STAGE(PG8_SB(1, 1), cB + hstepB + kstep, voffB);
    PG8_WAIT_V(6); PG8_BAR;
    for (;;) {
        const bool has_next = S.next(ui + 1, nxt);
        const char* nA = has_next ? nxt.A : cA; const char* nB = has_next ? nxt.B : cB;
        if (GATHER && has_next) S.a_rows(nxt, RA, CA2, lda, nva); else { nva[0][0] = va[0][0]; nva[0][1] = va[0][1]; nva[1][0] = va[1][0]; nva[1][1] = va[1][1]; }
        int nt_ = cur.nt; asm volatile("" : "+s"(nt_)); const int nt = nt_;
        for (int t = 0; t < nt; t += 2) {
            const bool last = (t == nt - 2);
            const char* a1 = cA + (size_t)(t + 1) * kstep;
            const char* a2 = last ? nA : cA + (size_t)(t + 2) * kstep; const char* b2 = last ? nB : cB + (size_t)(t + 2) * kstep;
            const char* a3 = a2 + kstep; const char* b3 = b2 + kstep;
            unsigned xv[2][2];
#pragma unroll
            for (int h = 0; h < 2; ++h)
#pragma unroll
                for (int i = 0; i < 2; ++i) xv[h][i] = (GATHER && last) ? nva[h][i] : va[h][i];
            PG8_LDB(B0, 0, 0); PG8_LDB(B1, 0, 1); PG8_SCHED; PG8_LDA(At, 0, 0); PG8_STAGE(PG8_SA(1, 1), a1, va[1]);
            PG8_WAIT_V(8); PG8_WAIT_L(0); PG8_BAR; PG8_MMA(0, 0, At, B0); PG8_MMA(0, 1, At, B1); PG8_BAR; PG8_SCHED;
            PG8_LDA(At, 0, 1); PG8_STAGE(PG8_SB(0, 0), b2, voffB); PG8_STAGE(PG8_SB(0, 1), b2 + hstepB, voffB); PG8_STAGE(PG8_SA(0, 0), a2, xv[0]);
            PG8_WAIT_V(8); PG8_WAIT_L(0); PG8_BAR; PG8_MMA(1, 0, At, B0); PG8_MMA(1, 1, At, B1); PG8_BAR; PG8_SCHED;
            PG8_LDB(B0, 1, 0); PG8_LDB(B1, 1, 1); PG8_SCHED; PG8_LDA(At, 1, 0); PG8_STAGE(PG8_SA(0, 1), a2, xv[1]);
            PG8_WAIT_V(8); PG8_WAIT_L(0); PG8_BAR; PG8_MMA(0, 0, At, B0); PG8_MMA(0, 1, At, B1); PG8_BAR; PG8_SCHED;
            PG8_LDA(At, 1, 1); PG8_STAGE(PG8_SB(1, 0), b3, voffB); PG8_STAGE(PG8_SB(1, 1), b3 + hstepB, voffB); PG8_STAGE(PG8_SA(1, 0), a3, xv[0]);
            PG8_WAIT_V(8); PG8_WAIT_L(0); PG8_BAR; PG8_MMA(1, 0, At, B0); PG8_MMA(1, 1, At, B1); PG8_BAR; PG8_SCHED;
        }
        if (wr == 0) PG8_BAR;
        { int tid_e = tid, fr_e = fr, fq_e = fq; asm volatile("" : "+v"(tid_e), "+v"(fr_e), "+v"(fq_e));
          E(acc, cur, tid_e, wr, wc, fr_e, fq_e); }
        if (!has_next) break;
#pragma unroll
        for (int a = 0; a < 2; ++a)
#pragma unroll
            for (int b = 0; b < 2; ++b)
#pragma unroll
                for (int m = 0; m < 4; ++m)
#pragma unroll
                    for (int n = 0; n < 2; ++n) acc[a][b][m][n] = (f32x4){0.f, 0.f, 0.f, 0.f};
        cur = nxt; cA = nA; cB = nB; ++ui;
#pragma unroll
        for (int h = 0; h < 2; ++h)
#pragma unroll
            for (int i = 0; i < 2; ++i) va[h][i] = nva[h][i];
        if (wr == 1) PG8_BAR;
    }
    PG8_WAIT_V(0);
    PG8_BAR;
#undef PG8_SA
#undef PG8_SB
#undef PG8_STAGE
#undef PG8_LDA
#undef PG8_LDB
#undef PG8_MMA
#undef PG8_WAIT_V
#undef PG8_WAIT_L
#undef PG8_BAR
#undef PG8_SCHED
}
struct PlainRows { __device__ __forceinline__ void a_rows(const Unit&, const int (&RA)[2], const int (&CA2)[2], int lda, unsigned (&va)[2][2]) const {
#pragma unroll
    for (int h = 0; h < 2; ++h)
#pragma unroll
        for (int i = 0; i < 2; ++i) va[h][i] = (unsigned)((h * HALF + RA[i]) * lda + CA2[i]); } };
}

struct GridSched : pg8::PlainRows {
    const char* A; const char* B; int nM, nN, nt, G, c, lda, ldb;
    __device__ __forceinline__ bool next(int i, pg8::Unit& u) const {
        const int nwg = nM * nN; const long L = (long)i * G + c; if (L >= nwg) return false;
        int wgid = (int)L; { const int q = nwg / 8, r = nwg % 8, xcd = wgid % 8, off = wgid / 8; wgid = (xcd < r ? xcd * (q + 1) : r * (q + 1) + (xcd - r) * q) + off; }
        const int nig = 8 * nN, gid = wgid / nig, fm = gid * 8, gsz = (nM - fm) < 8 ? (nM - fm) : 8;
        u.pm = fm + ((wgid % nig) % gsz); u.pn = (wgid % nig) / gsz; u.nt = nt; u.aux = 0;
        u.A = A + (size_t)u.pm * 256 * lda; u.B = B + (size_t)u.pn * 256 * ldb; return true; }
};
__device__ __forceinline__ u32x4 pack8(const f32x4& v0, const f32x4& v1) { u32x4 w; w.x = cvtpk(v0[0], v0[1]); w.y = cvtpk(v0[2], v0[3]); w.z = cvtpk(v1[0], v1[1]); w.w = cvtpk(v1[2], v1[3]); return w; }
struct EpiStoreBf16 { bf16* O; int ldc;
    __device__ __forceinline__ void operator()(const f32x4 (&acc)[2][2][4][2], const pg8::Unit& u, int tid, int wr, int wc, int fr, int fq) const {
        const int row0 = u.pm * 256 + wr * 64 + fr, col0 = u.pn * 256 + wc * 32 + 8 * fq;
#pragma unroll
        for (int ai = 0; ai < 2; ++ai)
#pragma unroll
            for (int m = 0; m < 4; ++m) { bf16* rowp = O + (size_t)(row0 + ai * 128 + m * 16) * ldc + col0;
#pragma unroll
                for (int bj = 0; bj < 2; ++bj) *(u32x4*)(rowp + bj * 128) = pack8(acc[ai][bj][m][0], acc[ai][bj][m][1]); } }
};
struct EpiResidBf16 { const bf16* X; bf16* Y; float alpha;
    __device__ __forceinline__ void operator()(const f32x4 (&acc)[2][2][4][2], const pg8::Unit& u, int tid, int wr, int wc, int fr, int fq) const {
        const int row0 = u.pm * 256 + wr * 64 + fr, col0 = u.pn * 256 + wc * 32 + 8 * fq;
#pragma unroll
        for (int ai = 0; ai < 2; ++ai)
#pragma unroll
            for (int m = 0; m < 4; ++m) { const size_t base = (size_t)(row0 + ai * 128 + m * 16) * DM + col0;
#pragma unroll
                for (int bj = 0; bj < 2; ++bj) { const u32x4 xw = *(const u32x4*)(X + base + bj * 128);
                    const f32x4 x0 = (f32x4){bflo(xw.x), bfhi(xw.x), bflo(xw.y), bfhi(xw.y)}, x1 = (f32x4){bflo(xw.z), bfhi(xw.z), bflo(xw.w), bfhi(xw.w)};
                    *(u32x4*)(Y + base + bj * 128) = pack8(x0 * alpha + acc[ai][bj][m][0], x1 * alpha + acc[ai][bj][m][1]); } } }
};

#define XB_TMO      128
#define XB_XCNT(j)  (256  + 64 * (j))
#define XB_XSUB(j)  (1280 + 64 * (j))
#define XB_XGEN(j)  (2304 + 64 * (j))
#define XB_TOP      3328
#define XB_TOPGEN   3392
#define XCD_BAR_WORDS 3456
#define XB_SPIN_CAP (1u << 18)

__device__ __forceinline__ unsigned xb_ld(unsigned* p)              { return __hip_atomic_load(p, __ATOMIC_RELAXED, __HIP_MEMORY_SCOPE_AGENT); }
__device__ __forceinline__ unsigned xb_add(unsigned* p, unsigned v) { return __hip_atomic_fetch_add(p, v, __ATOMIC_RELAXED, __HIP_MEMORY_SCOPE_AGENT); }
__device__ __forceinline__ unsigned xb_xcc_id() { return (unsigned)__builtin_amdgcn_s_getreg((3 << 11) | 20) & 0xFu; }
#define XB_SPIN(cond, bar) do { unsigned _sp = 0; while (cond) { __builtin_amdgcn_s_sleep(1); \
    if ((++_sp & 255u) == 0u) { if (xb_ld(&(bar)[XB_TMO])) break; if (_sp > XB_SPIN_CAP) { atomicAdd(&(bar)[XB_TMO], 1u); break; } } } } while (0)

struct XcdBarrier {
    unsigned wv; unsigned* bar; unsigned x;
    volatile LAS unsigned* st;
};

#define XB_IS_T0(b) ((b).wv == 0u && lane_id_asm() == 0)
__device__ __forceinline__ XcdBarrier xcd_barrier_post(unsigned* bar, volatile LAS unsigned* st, unsigned wv) {
    XcdBarrier b; b.wv = wv; b.bar = bar; b.x = xb_xcc_id(); b.st = st;
    if (XB_IS_T0(b)) (void)xb_add(&bar[XB_XCNT(b.x)], 1u);
    return b;
}
__device__ __forceinline__ void xcd_barrier_complete(unsigned* bar, unsigned x, unsigned& nloc, unsigned& nx) {
    const unsigned G = gridDim.x * gridDim.y * gridDim.z;
    unsigned sum, cnt, mine, sp = 0u;
    for (;;) {
        sum = 0u; cnt = 0u; mine = 0u;
#pragma unroll
        for (unsigned j = 0; j < 16; ++j) { const unsigned c = xb_ld(&bar[XB_XCNT(j)]); sum += c; cnt += (c > 0u) ? 1u : 0u; mine = (j == x) ? c : mine; }
        if (sum == G) break;
        __builtin_amdgcn_s_sleep(1);
        if ((++sp & 255u) == 0u) { if (xb_ld(&bar[XB_TMO])) break; if (sp > XB_SPIN_CAP) { atomicAdd(&bar[XB_TMO], 1u); break; } }
    }
    nloc = mine > 0u ? mine : 1u; nx = cnt > 0u ? cnt : 1u;
}

__device__ __forceinline__ void xcd_barrier(const XcdBarrier& b) {
    asm volatile("s_waitcnt vmcnt(0)" ::: "memory");
    __syncthreads();
    if (XB_IS_T0(b)) {
        unsigned* bar = b.bar;
        __builtin_amdgcn_s_waitcnt(0);
        unsigned nloc = b.st[0], nx = b.st[1];
        if (nloc == 0u) { xcd_barrier_complete(bar, b.x, nloc, nx); b.st[0] = nloc; b.st[1] = nx; }
        const unsigned old = xb_add(&bar[XB_XSUB(b.x)], 1u);
        const unsigned gen = old / nloc;
        if (old + 1u == (gen + 1u) * nloc) {
            __builtin_amdgcn_fence(__ATOMIC_RELEASE, "agent");
            asm volatile("s_waitcnt vmcnt(0)" ::: "memory");
            const unsigned og = xb_add(&bar[XB_TOP], 1u);
            const unsigned tg = og / nx;
            if (og + 1u == (tg + 1u) * nx) xb_add(&bar[XB_TOPGEN], 1u);
            else XB_SPIN(xb_ld(&bar[XB_TOPGEN]) == tg, bar);
            __builtin_amdgcn_fence(__ATOMIC_ACQUIRE, "agent");
            xb_add(&bar[XB_XGEN(b.x)], 1u);
            asm volatile("s_waitcnt vmcnt(0)" ::: "memory");
        } else {
            XB_SPIN(xb_ld(&bar[XB_XGEN(b.x)]) == gen, bar);
            __builtin_amdgcn_fence(__ATOMIC_ACQUIRE, "agent");
            asm volatile("s_waitcnt vmcnt(0)" ::: "memory");
        }
    }
    __syncthreads();
}

struct Ctx {
    float* hf; unsigned char* ws; LAS unsigned char* lds;
    int tid, lane, wave, gw, ngw, G;
};
#define WSP(type, off) ((type*)(C.ws + (off)))
__device__ __forceinline__ Ctx fresh(const Ctx& C0) { Ctx C = C0; int w = C.wave; asm volatile("" : "+s"(w)); C.wave = w; C.lane = lane_id_asm(); C.tid = w * 64 + C.lane; C.gw = blockIdx.x * NWAVES + w; return C; }

__device__ __forceinline__ void ln_row(f32x4 (&v)[4], const float* g, const float* b, float* hfrow, bf16* hbrow, int lane) {
    float s = 0.f;
#pragma unroll
    for (int j = 0; j < 4; ++j) s += (v[j].x + v[j].y) + (v[j].z + v[j].w);
    const float mean = wave_sum_l(s, lane) * (1.f / DM); float s2 = 0.f;
#pragma unroll
    for (int j = 0; j < 4; ++j) { v[j] = v[j] - mean; s2 += (v[j].x * v[j].x + v[j].y * v[j].y) + (v[j].z * v[j].z + v[j].w * v[j].w); }
    const float rstd = 1.f / sqrtf(wave_sum_l(s2, lane) * (1.f / DM) + LN_EPS);
#pragma unroll
    for (int j = 0; j < 2; ++j) { const int c = 8 * lane + 512 * j;
        v[2 * j] = v[2 * j] * rstd * *(const f32x4*)(g + c) + *(const f32x4*)(b + c); v[2 * j + 1] = v[2 * j + 1] * rstd * *(const f32x4*)(g + c + 4) + *(const f32x4*)(b + c + 4);
        if (hfrow) { *(f32x4*)(hfrow + c) = v[2 * j]; *(f32x4*)(hfrow + c + 4) = v[2 * j + 1]; }
        u32x4 o; o.x = pk2(v[2 * j].x, v[2 * j].y); o.y = pk2(v[2 * j].z, v[2 * j].w); o.z = pk2(v[2 * j + 1].x, v[2 * j + 1].y); o.w = pk2(v[2 * j + 1].z, v[2 * j + 1].w); *(u32x4*)(hbrow + c) = o; }
}
__device__ __forceinline__ void ld8bf(const bf16* p, f32x4& a, f32x4& b) { const u32x4 w = *(const u32x4*)p; a = (f32x4){bflo(w.x), bfhi(w.x), bflo(w.y), bfhi(w.y)}; b = (f32x4){bflo(w.z), bfhi(w.z), bflo(w.w), bfhi(w.w)}; }
__device__ __forceinline__ f32x4 ld4bf(const bf16* p) { const u32x2 w = *(const u32x2*)p; return (f32x4){bflo(w.x), bfhi(w.x), bflo(w.y), bfhi(w.y)}; }

__device__ __forceinline__ void ph_prologue(const Args& A, const Ctx& C0) { const Ctx C = fresh(C0);
    LAS float* scr = (LAS float*)(C.lds + C.wave * CONV_SCR); int cbase = 0;
    for (int l = 0; l < NL; ++l) {
        unsigned char* wb = C.ws + WS_WSM + l * WSM_STRIDE;
        { const float* W = A.in[4] + (size_t)l * DM * DIN;
          auto f = [W](int k, int n) -> float { int src; float sc = 1.f;
              if (n < 1792) { src = n; if (n < 256) sc = SC32; else if (n >= 768 && n < 1024) sc = SC64; }
              else if (n < 2560) { src = 1952 + (n - 1792); if (n < 2048) sc = SC64; }
              else if (n < 2688) src = 1792 + (n - 2560);
              else if (n < 2720) { const int i = n - 2688; src = 1920 + (i & 1) * 16 + (i >> 1); }
              else if (n < 2724) src = n;
              else return 0.f;
              return W[(size_t)k * DIN + src] * sc; };
          conv_matrix(f, (bf16*)(wb + WO_WIN), NPROJ, DM, scr, C.lane, C.gw, C.ngw, cbase); }
        { const float* W = A.in[13] + (size_t)l * 4 * DM * DM;
          auto f = [W](int k, int R) -> float { const int grp = R >> 8, j = R & 255, n = ((j >> 7) << 1) | ((j >> 2) & 1), c = grp * 64 + ((j >> 5) & 3) * 16 + ((j >> 3) & 3) * 4 + (j & 3); return W[((size_t)n * DM + k) * DM + c]; };
          conv_matrix(f, (bf16*)(wb + WO_WG), 4 * DM, DM, scr, C.lane, C.gw, C.ngw, cbase); }
        { const float* W = A.in[15] + (size_t)l * 4 * 256 * DM;
          auto f = [W](int k, int n) -> float { return W[(size_t)k * DM + n]; };
          conv_matrix(f, (bf16*)(wb + WO_WB), DM, DM, scr, C.lane, C.gw, C.ngw, cbase); }
        { const float* W = A.in[16] + (size_t)l * DM * DM;
          auto f = [W](int k, int n) -> float { return W[(size_t)k * DM + n]; };
          conv_matrix(f, (bf16*)(wb + WO_WO), DM, DM, scr, C.lane, C.gw, C.ngw, cbase); }
        { const float* W = A.in[11] + (size_t)l * 256 * 384; const float* g = A.in[9] + l * 256;
          auto f = [W, g](int k, int n) -> float { if (n >= 384) return 0.f; const int h = n / 96, d = n % 96; int src = n;
              if (d >= 64) { const int i = d - 64; src = h * 96 + 64 + (i & 1) * 16 + (i >> 1); }
              return W[(size_t)k * 384 + src] * g[k] * SC96; };
          conv_matrix(f, (bf16*)(wb + WO_WUQ), 512, 256, scr, C.lane, C.gw, C.ngw, cbase); }
        { const float* W = A.in[12] + (size_t)l * 128 * 512; const float* g = A.in[10] + l * 128;
          auto f = [W, g](int k, int n) -> float { if (k >= 128) return 0.f; const int src = (n < 256) ? ((n >> 6) * 128 + (n & 63)) : (((n - 256) >> 6) * 128 + 64 + (n & 63));
              return W[(size_t)k * 512 + src] * g[k]; };
          conv_matrix(f, (bf16*)(wb + WO_WUKV), 512, 256, scr, C.lane, C.gw, C.ngw, cbase); }
    }
    { float* rope = WSP(float, WS_MISC + MO_ROPE); const int gt = C.gw * 64 + C.lane, ngt = C.ngw * 64;
      for (int i = gt; i < SEQ * 16; i += ngt) { const int pos = i >> 4, f = i & 15;
          const float invf = powf(10000.0f, -(float)f * 2.0f / 32.0f); const float ang = (float)pos * invf; float s, c; sincos_acc(ang, s, c);
          rope[2 * i] = c; rope[2 * i + 1] = s; }
      float* bt = WSP(float, WS_MISC + MO_T5);
      for (int i = gt; i < NL * 2 * 4 * 320; i += ngt) { const int rel = (i % 320) - 256, h = (i / 320) & 3, ty = (i / 1280) & 1, l = i / 2560; float v;
          if (ty == 0) { const int n = rel < 0 ? -rel : rel; int bk;
              if (n < 8) bk = n; else if (n < 12) bk = 8; else if (n < 16) bk = 9; else if (n < 23) bk = 10; else if (n < 32) bk = 11; else if (n < 46) bk = 12; else if (n < 64) bk = 13; else if (n < 91) bk = 14; else bk = 15;
              if (rel > 0) bk += 16;
              v = A.in[3][bk * 4 + h] - A.in[3][15 * 4 + h]; }
          else { const int rc = rel < -128 ? -128 : rel; const float* rb = A.in[8] + (size_t)l * 257 * 4; v = rb[(rc + 128) * 4 + h] - rb[h]; }
          bt[i] = v * LOG2E; } }
    { float* wrt = WSP(float, WS_MISC + MO_WRT); const int gt = C.gw * 64 + C.lane, ngt = C.ngw * 64;
      for (int i = gt; i < NL * 36 * DM; i += ngt) { const int k = i & (DM - 1), e = (i >> 10) % 36, l = i / (36 * DM);
          wrt[i] = e < 4 ? A.in[19][((size_t)l * DM + k) * 4 + e] : A.in[21][((size_t)l * DM + k) * 32 + (e - 4)]; } }
    bf16* hb = WSP(bf16, WS_HB);
    for (int m = 2 * C.gw; m < NT; m += 2 * C.ngw) { f32x4 v[2][4];
#pragma unroll
        for (int r = 0; r < 2; ++r)
#pragma unroll
            for (int j = 0; j < 4; ++j) v[r][j] = *(const f32x4*)(A.in[0] + (size_t)(m + r) * DM + 8 * C.lane + 512 * (j >> 1) + 4 * (j & 1));
#pragma unroll
        for (int r = 0; r < 2; ++r) ln_row(v[r], A.in[1], A.in[2], nullptr, hb + (size_t)(m + r) * DM, C.lane); }
}

__device__ __forceinline__ float log_sigmoid(float x) { return fminf(x, 0.f) - log1pf(expf(-fabsf(x))); }
struct EpiProj { bf16* O; float* rstd; const float* rope; bf16* mk; float* sum64; const float* bfg; LAS float* xl;
    __device__ __forceinline__ void operator()(const f32x4 (&acc)[2][2][4][2], const pg8::Unit& u, int tid, int wr, int wc, int fr, int fq) const {
        const int row0 = u.pm * 256 + wr * 64 + fr, col0 = u.pn * 256 + wc * 32 + 8 * fq; const int lane = tid & 63;
        const bool stat = (u.pn == 6 || u.pn == 10);
        float ssq[2][4];
#pragma unroll
        for (int ai = 0; ai < 2; ++ai)
#pragma unroll
            for (int m = 0; m < 4; ++m) { bf16* rowp = O + (size_t)(row0 + ai * 128 + m * 16) * NPROJ + col0; float q = 0.f;
#pragma unroll
                for (int bj = 0; bj < 2; ++bj) { const u32x4 w = pack8(acc[ai][bj][m][0], acc[ai][bj][m][1]); *(u32x4*)(rowp + bj * 128) = w;
                    if (stat && (u.pn == 6 || bj == 0)) q += (bflo(w.x) * bflo(w.x) + bfhi(w.x) * bfhi(w.x)) + (bflo(w.y) * bflo(w.y) + bfhi(w.y) * bfhi(w.y)) + (bflo(w.z) * bflo(w.z) + bfhi(w.z) * bfhi(w.z)) + (bflo(w.w) * bflo(w.w) + bfhi(w.w) * bfhi(w.w));
                    if (u.pn == 10 && bj == 1) {
                        if (wc == 0) {
                            const int row = row0 + ai * 128 + m * 16, pos = row & (SEQ - 1); const float* rp = rope + ((size_t)pos * 16 + 4 * fq) * 2; const f32x4 ra = *(const f32x4*)rp, rb = *(const f32x4*)(rp + 4);
                            const f32x4 t0 = {bflo(w.x), bfhi(w.x), bflo(w.y), bfhi(w.y)}, t1 = {bflo(w.z), bfhi(w.z), bflo(w.w), bfhi(w.w)};
                            const f32x4 r0 = {t0[0] * ra[0] - t0[1] * ra[1], t0[0] * ra[1] + t0[1] * ra[0], t0[2] * ra[2] - t0[3] * ra[3], t0[2] * ra[3] + t0[3] * ra[2]};
                            const f32x4 r1 = {t1[0] * rb[0] - t1[1] * rb[1], t1[0] * rb[1] + t1[1] * rb[0], t1[2] * rb[2] - t1[3] * rb[3], t1[2] * rb[3] + t1[3] * rb[2]};
                            const u32x4 ow = pack8(r0, r1);
#pragma unroll
                            for (int h = 0; h < 4; ++h) *(u32x4*)(mk + (size_t)row * 384 + h * 96 + 64 + 8 * fq) = ow; } } }
                ssq[ai][m] = q; }
        if (u.pn == 10 && wc == 1) {
#pragma unroll
            for (int ai = 0; ai < 2; ++ai) { f32x4 sm = {0.f, 0.f, 0.f, 0.f};
#pragma unroll
                for (int m = 0; m < 4; ++m) { const u32x4 w = pack8(acc[ai][1][m][0], acc[ai][1][m][1]); const float x[4] = {bflo(w.x), bfhi(w.x), bflo(w.y), bfhi(w.y)};
#pragma unroll
                    for (int h = 0; h < 4; ++h) sm[h] += log_sigmoid(x[h] + bfg[h]) * LOG2E; }
#pragma unroll
                for (int h = 0; h < 4; ++h) {
#pragma unroll
                    for (int o = 1; o < 16; o <<= 1) sm[h] += shfl_xor_l(sm[h], o, lane); }
                if (lane == 0) *(f32x4*)(sum64 + (size_t)((u.pm * 2 + ai) * 2 + wr) * 4) = sm; } }
        if (stat) {
#pragma unroll
            for (int ai = 0; ai < 2; ++ai)
#pragma unroll
                for (int m = 0; m < 4; ++m) { float q = ssq[ai][m]; q += shfl_xor_l(q, 16, lane); q += shfl_xor_l(q, 32, lane); if (fq == 0) xl[wc * 256 + ai * 128 + wr * 64 + m * 16 + fr] = q; }
            asm volatile("s_waitcnt lgkmcnt(0)\n\ts_barrier" ::: "memory");
            if (tid < 256) { const float t = (xl[tid] + xl[256 + tid]) + (xl[512 + tid] + xl[768 + tid]);
                if (u.pn == 6) rstd[2 * (u.pm * 256 + tid)] = 1.f / sqrtf(t * (1.f / 256) + LN_EPS); else rstd[2 * (u.pm * 256 + tid) + 1] = 1.f / sqrtf(t * (1.f / 128) + LN_EPS); }
            asm volatile("s_waitcnt lgkmcnt(0)\n\ts_barrier" ::: "memory"); }
    }
};
__device__ __forceinline__ void ph_proj(const Args& A, const Ctx& C0, int l) { const Ctx C = fresh(C0);
    GridSched S; S.A = (const char*)WSP(bf16, WS_HB); S.B = (const char*)WSP(bf16, WS_WSM + l * WSM_STRIDE + WO_WIN); S.nM = NT / 256; S.nN = NPROJ / 256; S.nt = DM / 64; S.G = C.G; S.c = blockIdx.x; S.lda = DM * 2; S.ldb = DM * 2;
    EpiProj E{WSP(bf16, WS_R1), WSP(float, WS_MISC + MO_RSTD), WSP(float, WS_MISC + MO_ROPE), WSP(bf16, WS_R2 + 24 * MiB), WSP(float, WS_MISC + MO_SUM64), A.in[5] + l * 4, (LAS float*)(C.lds + LDS_TAB)};
    pg8::gemm_phase<false>(C.lds, C.tid, DM * 2, DM * 2, S, E);
}

__device__ __forceinline__ void fox_tables(const Args& A, const Ctx& C, int l) {
    const bf16* proj = WSP(bf16, WS_R1); const float* sum64 = WSP(float, WS_MISC + MO_SUM64); float* cum = WSP(float, WS_MISC + MO_CUM); const float* bf = A.in[5] + l * 4;
    LAS float* wt = (LAS float*)(C.lds + LDS_TAB);
    for (int blk = blockIdx.x; blk < NT / 128; blk += C.G) { const int b = blk / (SEQ / 128);
        __syncthreads();
        if (C.tid < 128) { const int idx = b * (SEQ / 64) + C.tid; f32x4 p = idx < blk * 2 ? *(const f32x4*)(sum64 + (size_t)idx * 4) : (f32x4){0.f, 0.f, 0.f, 0.f};
#pragma unroll
            for (int h = 0; h < 4; ++h) p[h] = wave_sum_l(p[h], C.lane);
            if (C.lane == 0) *(LAS f32x4*)(wt + C.wave * 4) = p; }
        float ls[4] = {0.f, 0.f, 0.f, 0.f}, inc[4];
        if (C.tid < 128) { const u32x2 ff = *(const u32x2*)(proj + (size_t)(blk * 128 + C.tid) * NPROJ + PC_FF); const float x[4] = {bflo(ff.x), bfhi(ff.x), bflo(ff.y), bfhi(ff.y)};
#pragma unroll
            for (int h = 0; h < 4; ++h) ls[h] = log_sigmoid(x[h] + bf[h]) * LOG2E; }
#pragma unroll
        for (int h = 0; h < 4; ++h) { float v = ls[h];
#pragma unroll
            for (int o = 1; o < 64; o <<= 1) { const float y = shfl_up_l(v, o, C.lane); if (C.lane >= o) v += y; }
            inc[h] = v; if (C.tid == 63) wt[8 + h] = v; }
        __syncthreads();
        if (C.tid < 128) { const int t = (blk * 128 + C.tid) & (SEQ - 1);
#pragma unroll
            for (int h = 0; h < 4; ++h) cum[(size_t)(b * 4 + h) * SEQ + t] = (wt[h] + wt[4 + h]) + (C.wave == 1 ? wt[8 + h] : 0.f) + inc[h]; }
        float mq2 = 0.f, mk2 = 0.f;
        for (int i = 0; i < 16; ++i) { const bf16* row = proj + (size_t)(blk * 128 + C.wave * 16 + i) * NPROJ;
            const u32x2 fq = *(const u32x2*)(row + PC_FQ + 4 * C.lane), fk = *(const u32x2*)(row + PC_FK + 4 * C.lane);
            float a = bflo(fq.x) * bflo(fq.x) + bfhi(fq.x) * bfhi(fq.x) + bflo(fq.y) * bflo(fq.y) + bfhi(fq.y) * bfhi(fq.y);
            float b2 = bflo(fk.x) * bflo(fk.x) + bfhi(fk.x) * bfhi(fk.x) + bflo(fk.y) * bflo(fk.y) + bfhi(fk.y) * bfhi(fk.y);
#pragma unroll
            for (int o = 1; o < 16; o <<= 1) { a += shfl_xor_l(a, o, C.lane); b2 += shfl_xor_l(b2, o, C.lane); }
            mq2 = fmaxf(mq2, a); mk2 = fmaxf(mk2, b2); }
        unsigned* qkm = WSP(unsigned, WS_CTL) + CW_QKMAX + l * 32;
        if ((C.lane & 15) == 0) { atomicMax(qkm + b * 4 + (C.lane >> 4), __float_as_uint(mq2)); atomicMax(qkm + 16 + b * 4 + (C.lane >> 4), __float_as_uint(mk2)); }
    }
    __syncthreads();
}

struct MlaSched : pg8::PlainRows { const char* proj; const char* Wq; const char* Wkv; int G, c;
    __device__ __forceinline__ bool next(int i, pg8::Unit& u) const { const int cx = (G & 7) == 0 ? (c & 7) * (G >> 3) + (c >> 3) : c; const int L = i * G + cx; if (L >= (NT / 256) * 4) return false;
        const int pm = L >> 2, kind = (L >> 1) & 1, pn = L & 1; u.pm = pm; u.pn = pn; u.nt = 4; u.aux = kind;
        u.A = proj + (size_t)pm * 256 * (NPROJ * 2) + (kind ? PC_CKV : PC_CQ) * 2; u.B = (kind ? Wkv : Wq) + (size_t)pn * 256 * 512; return true; } };
struct EpiMla { const float* rstd; const float* rope; bf16* mq; bf16* mk; bf16* mv;
    __device__ __forceinline__ void operator()(const f32x4 (&acc)[2][2][4][2], const pg8::Unit& u, int tid, int wr, int wc, int fr, int fq) const {
        const int row0 = u.pm * 256 + wr * 64 + fr;
        if (u.aux == 0) {
#pragma unroll
            for (int ai = 0; ai < 2; ++ai)
#pragma unroll
                for (int m = 0; m < 4; ++m) { asm volatile("" ::: "memory"); const int row = row0 + ai * 128 + m * 16; const float rs = rstd[2 * row]; const int pos = row & (SEQ - 1);
#pragma unroll
                    for (int bj = 0; bj < 2; ++bj) { const int col0 = u.pn * 256 + bj * 128 + wc * 32 + 8 * fq; f32x4 v0 = acc[ai][bj][m][0] * rs, v1 = acc[ai][bj][m][1] * rs;
                        if (col0 < 384) { const int d0 = col0 % 96;
                            if (d0 >= 64) { const float* rp = rope + ((size_t)pos * 16 + ((d0 - 64) >> 1)) * 2; const f32x4 ra = *(const f32x4*)rp, rb = *(const f32x4*)(rp + 4);
                                const f32x4 t0 = v0, t1 = v1;
                                v0[0] = t0[0] * ra[0] - t0[1] * ra[1]; v0[1] = t0[0] * ra[1] + t0[1] * ra[0]; v0[2] = t0[2] * ra[2] - t0[3] * ra[3]; v0[3] = t0[2] * ra[3] + t0[3] * ra[2];
                                v1[0] = t1[0] * rb[0] - t1[1] * rb[1]; v1[1] = t1[0] * rb[1] + t1[1] * rb[0]; v1[2] = t1[2] * rb[2] - t1[3] * rb[3]; v1[3] = t1[2] * rb[3] + t1[3] * rb[2]; }
                            *(u32x4*)(mq + (size_t)row * 384 + col0) = pack8(v0, v1); } } }
        } else {
#pragma unroll
            for (int ai = 0; ai < 2; ++ai)
#pragma unroll
                for (int m = 0; m < 4; ++m) { asm volatile("" ::: "memory"); const int row = row0 + ai * 128 + m * 16; const float rs = rstd[2 * row + 1];
#pragma unroll
                    for (int bj = 0; bj < 2; ++bj) { const int col0 = u.pn * 256 + bj * 128 + wc * 32 + 8 * fq; const f32x4 v0 = acc[ai][bj][m][0] * rs, v1 = acc[ai][bj][m][1] * rs;
                        if (col0 < 256) *(u32x4*)(mk + (size_t)row * 384 + (col0 >> 6) * 96 + (col0 & 63)) = pack8(v0, v1); else *(u32x4*)(mv + (size_t)row * 256 + (col0 - 256)) = pack8(v0, v1); } }
        } }
};
__device__ __forceinline__ void ph_mla_up(const Args& A, const Ctx& C0, int l) { const Ctx C = fresh(C0);
    fox_tables(A, C, l);
    MlaSched S; S.proj = (const char*)WSP(bf16, WS_R1); S.Wq = (const char*)WSP(bf16, WS_WSM + l * WSM_STRIDE + WO_WUQ); S.Wkv = (const char*)WSP(bf16, WS_WSM + l * WSM_STRIDE + WO_WUKV); S.G = C.G; S.c = blockIdx.x;
    EpiMla E{WSP(float, WS_MISC + MO_RSTD), WSP(float, WS_MISC + MO_ROPE), WSP(bf16, WS_R2), WSP(bf16, WS_R2 + 24 * MiB), WSP(bf16, WS_R2 + 48 * MiB)};
    pg8::gemm_phase<false>(C.lds, C.tid, NPROJ * 2, 512, S, E);
}

typedef short s16x4 __attribute__((ext_vector_type(4)));
typedef __attribute__((address_space(3))) const char* lds_cptr;
constexpr int AT_K = 0, AT_KSLOT = 16384, AT_V = 49152, AT_VSLOT = 8192, AT_TAB = 81920, AT_CK = 83968;
constexpr float AT_THR = 8.f;
__device__ __forceinline__ s16x4 vtr(lds_cptr p) { return __builtin_bit_cast(s16x4, __builtin_amdgcn_ds_read_tr16_b64_v4i16((__attribute__((address_space(3))) s16x4*)p)); }
__device__ __forceinline__ float swapmax(float m) { auto rr = __builtin_amdgcn_permlane32_swap(__float_as_uint(m), __float_as_uint(m), false, false); return fmaxf(__uint_as_float(rr[0]), __uint_as_float(rr[1])); }
__device__ __forceinline__ float swapsum(float m) { auto rr = __builtin_amdgcn_permlane32_swap(__float_as_uint(m), __float_as_uint(m), false, false); return __uint_as_float(rr[0]) + __uint_as_float(rr[1]); }
#define AT_WAITBAR(N) asm volatile("s_waitcnt vmcnt(" #N ") lgkmcnt(0)\n\ts_barrier" ::: "memory")
#define MX3(a, b, c) __builtin_fmaxf(__builtin_fmaxf((a), (b)), (c))

struct AttnSrc { const bf16* Q; const bf16* K; const bf16* V; int qp, kp, vp; };

template <int TYPE> __device__ __forceinline__ void attn_unit(const Ctx& C, const AttnSrc& S, int qb, const float* gtab, const float* cumT, bf16* Odst, float lam_full, float lam_init, const float* dng, float bqk) {
    constexpr int DQ = TYPE == 2 ? 96 : 64, NMAP = TYPE == 0 ? 2 : 1, DMAP = DQ / NMAP, NKS = DMAP / 16;
    int lane_ = C.lane, wid_ = C.wave; asm volatile("" : "+v"(lane_), "+s"(wid_));
    const int lane = lane_, r32 = lane & 31, hi = lane >> 5, wid = wid_;
    const int q0 = qb * 256, qw = q0 + wid * 32, q = qw + r32, cw = qw >> 6;
    const int thi = 4 * qb + 3, thi_w = cw; const bool lag = wid >= 4;
    int tlo = TYPE == 1 ? (4 * qb - 8 > 0 ? 4 * qb - 8 : 0) : 0, tlo_w = TYPE == 1 ? (cw - 8 > 0 ? cw - 8 : 0) : 0;
    if (TYPE == 3) {
        const float d0 = cumT[q0] + 2.f * bqk + 40.f; const int t0 = lane, t1 = 64 + lane;
        const bool ok0 = (t0 <= thi) && (d0 - cumT[t0 * 64 + 63] >= 0.f), ok1 = (t1 <= thi) && (d0 - cumT[t1 * 64 + 63] >= 0.f);
        const unsigned long long m0 = __ballot(ok0), m1 = __ballot(ok1);
        tlo = m0 ? (int)__builtin_ctzll(m0) : (m1 ? 64 + (int)__builtin_ctzll(m1) : thi); tlo = __builtin_amdgcn_readfirstlane(tlo); if (tlo > 4 * qb) tlo = 4 * qb; tlo_w = tlo; }
    const unsigned lds0 = (unsigned)(uintptr_t)C.lds;
    LAS float* tab = (LAS float*)(C.lds + AT_TAB); LAS float* ckl = (LAS float*)(C.lds + AT_CK);
    const unsigned koff = (unsigned)(lane * S.kp + wid * 8) * 2u, voffv = (unsigned)((16 * (wid & 3) + (lane >> 2)) * S.vp + (wid >> 2) * 32 + (lane & 3) * 8) * 2u;
    const int k2 = (wid < 4 ? 8 : 4) * 16;
    const unsigned kdst = lds0 + AT_K + wid * 1024, vdst = lds0 + AT_V + wid * 1024;
#define AT_ISSUE_K(t, ks) do { const char* kb_ = (const char*)S.K + (size_t)(t) * 128 * S.kp; \
        glds16(kb_, koff, (unsigned)__builtin_amdgcn_readfirstlane(kdst + (ks) * AT_KSLOT)); \
        if (TYPE == 2) glds16(kb_ + k2, koff, (unsigned)__builtin_amdgcn_readfirstlane(kdst + (ks) * AT_KSLOT + 8192)); } while (0)
#define AT_ISSUE_V(t, vs) glds16((const char*)S.V + (size_t)(t) * 128 * S.vp, voffv, (unsigned)__builtin_amdgcn_readfirstlane(vdst + (vs) * AT_VSLOT))
    constexpr bool KPIPE = false, FOLD = true;
    AT_ISSUE_K(tlo, 0); AT_ISSUE_V(tlo, 0);
    if (tlo + 1 <= thi) { AT_ISSUE_K(tlo + 1, 1); AT_ISSUE_V(tlo + 1, 1); }
    if (KPIPE && tlo + 2 <= thi) AT_ISSUE_K(tlo + 2, 2);
    bf16x8 qr[NMAP][NKS];
#pragma unroll
    for (int m = 0; m < NMAP; ++m)
#pragma unroll
        for (int d0 = 0; d0 < NKS; ++d0) qr[m][d0] = *(const bf16x8*)(S.Q + (size_t)q * S.qp + m * DMAP + d0 * 16 + hi * 8);
    const int tid = wid * 64 + lane;
    if (TYPE == 0 || TYPE == 1) { if (tid < 320) tab[tid] = gtab[tid]; }
    float cq = 0.f;
    if (TYPE == 3) { for (int i = tid; i < q0 + 256 - tlo * 64; i += NTHR) ckl[i] = cumT[tlo * 64 + i]; cq = cumT[q]; }
    f32x16 o[NMAP][2], negm; float mhat = 0.f, lsum[NMAP]; u32x4 pw[NMAP][4];
#pragma unroll
    for (int r = 0; r < 16; ++r) negm[r] = cq;
#pragma unroll
    for (int m = 0; m < NMAP; ++m) { o[m][0] = f32x16{}; o[m][1] = f32x16{}; lsum[m] = 0.f;
#pragma unroll
        for (int i = 0; i < 4; ++i) pw[m][i] = (u32x4){0u, 0u, 0u, 0u}; }
#pragma unroll
    for (int m = 0; m < NMAP; ++m)
#pragma unroll
        for (int d0 = 0; d0 < NKS; ++d0) asm volatile("" : "+v"(qr[m][d0]));
    asm volatile("" : "+v"(cq));
    const lds_cptr kp0 = (lds_cptr)C.lds + AT_K + hi * 1024 + r32 * 16;
    const lds_cptr vp0 = (lds_cptr)C.lds + AT_V + ((lane >> 4) & 1) * 32 + (lane & 3) * 8 + (4 * hi + ((lane & 15) >> 2)) * 64;
    s16x4 vl[8], vh[8];
#define AT_VLOAD(vs_, i0, i1) do { const lds_cptr vp_ = vp0 + (vs_) * AT_VSLOT; \
        _Pragma("unroll") for (int i_ = (i0); i_ < (i1); ++i_) { vl[i_] = vtr(vp_ + ((i_ >> 2) * 4096 + (i_ & 3) * 1024)); vh[i_] = vtr(vp_ + ((i_ >> 2) * 4096 + (i_ & 3) * 1024 + 512)); } } while (0)
#define AT_VF(i_) (bf16x8){vl[i_][0], vl[i_][1], vl[i_][2], vl[i_][3], vh[i_][0], vh[i_][1], vh[i_][2], vh[i_][3]}
#define AT_PV(m, ALT) do { __builtin_amdgcn_s_setprio(1); \
        if (ALT) { _Pragma("unroll") for (int ks_ = 0; ks_ < 4; ++ks_) { o[m][0] = MFMA32(AT_VF(ks_), __builtin_bit_cast(bf16x8, pw[m][ks_]), o[m][0]); o[m][1] = MFMA32(AT_VF(4 + ks_), __builtin_bit_cast(bf16x8, pw[m][ks_]), o[m][1]); } } \
        else { _Pragma("unroll") for (int ks_ = 0; ks_ < 4; ++ks_) o[m][0] = MFMA32(AT_VF(ks_), __builtin_bit_cast(bf16x8, pw[m][ks_]), o[m][0]); \
               _Pragma("unroll") for (int ks_ = 0; ks_ < 4; ++ks_) o[m][1] = MFMA32(AT_VF(4 + ks_), __builtin_bit_cast(bf16x8, pw[m][ks_]), o[m][1]); } \
        __builtin_amdgcn_s_setprio(0); } while (0)
    int ks = 0, vs = 0, vprev = 0; bool pend = false;
    bf16x8 kf[1][NKS][2];
#define AT_KLOAD(ks_) do { const lds_cptr kp_ = kp0 + (ks_) * AT_KSLOT; \
        _Pragma("unroll") for (int d0 = 0; d0 < NKS; ++d0) { const int cb = d0 * 2048; \
            kf[0][d0][0] = *(const __attribute__((address_space(3))) bf16x8*)(kp_ + cb); kf[0][d0][1] = *(const __attribute__((address_space(3))) bf16x8*)(kp_ + cb + 512); } } while (0)
    if (KPIPE) { AT_WAITBAR(0);
        if (tlo_w == tlo) AT_KLOAD(0); }
    for (int t = tlo; t <= thi; ++t) {
        if (!KPIPE || t > tlo) { if (t + 1 <= thi) { if (TYPE == 2) AT_WAITBAR(3); else AT_WAITBAR(2); } else AT_WAITBAR(0); }
        if (KPIPE) { if (t + 3 <= thi) AT_ISSUE_K(t + 3, ks); }
        else if (t + 2 <= thi) AT_ISSUE_K(t + 2, ks >= 1 ? ks - 1 : 2);
        if (t + 2 <= thi) AT_ISSUE_V(t + 2, (vs + 2) & 3);
        if (pend) { AT_VLOAD(vprev, 0, 8); AT_PV(NMAP - 1, true); pend = false; }
        const int ksn = ks == 2 ? 0 : ks + 1;
        if (t >= tlo_w && t <= thi_w) {
            const bool first = (t == tlo_w);
#pragma unroll
            for (int m = 0; m < NMAP; ++m) {
                const bool pvnow = !lag || m < NMAP - 1;
                __builtin_amdgcn_sched_barrier(0);
                f32x16 s0 = FOLD ? negm : f32x16{}, s1 = FOLD ? negm : f32x16{};
                if (!KPIPE) { const lds_cptr kp_ = kp0 + ks * AT_KSLOT;
#pragma unroll
                    for (int d0 = 0; d0 < NKS; ++d0) { const int cb = (m * NKS + d0) * 2048;
                        kf[0][d0][0] = *(const __attribute__((address_space(3))) bf16x8*)(kp_ + cb); kf[0][d0][1] = *(const __attribute__((address_space(3))) bf16x8*)(kp_ + cb + 512); }
                    if (pvnow) AT_VLOAD(vs, 0, 4);
                    __builtin_amdgcn_sched_barrier(0); }
                __builtin_amdgcn_s_setprio(1);
#pragma unroll
                for (int d0 = 0; d0 < NKS; ++d0) { s0 = MFMA32(kf[0][d0][0], qr[m][d0], s0); s1 = MFMA32(kf[0][d0][1], qr[m][d0], s1); }
                __builtin_amdgcn_s_setprio(0);
                if (KPIPE) { if (pvnow) AT_VLOAD(vs, 0, 4);
                    if (t + 1 <= thi_w) AT_KLOAD(ksn); }
                if (TYPE == 0 || TYPE == 1) { if (t * 64 + 63 - qw > -128) { const LAS float* tb = tab + (t * 64 - q + 256);
#pragma unroll
                    for (int r = 0; r < 16; ++r) { s0[r] += tb[crow(r, hi)]; s1[r] += tb[32 + crow(r, hi)]; } } }
                if (TYPE == 3) { const LAS float* cb = ckl + (t - tlo) * 64 + 4 * hi;
#pragma unroll
                    for (int g = 0; g < 4; ++g) { const f32x4 c0 = *(const LAS f32x4*)(cb + 8 * g), c1 = *(const LAS f32x4*)(cb + 32 + 8 * g);
#pragma unroll
                        for (int i = 0; i < 4; ++i) { s0[4 * g + i] -= c0[i]; s1[4 * g + i] -= c1[i]; } }
                    if (t == cw) { const int kb = t * 64 + 4 * hi;
#pragma unroll
                        for (int r = 0; r < 16; ++r) { const int kv = kb + (r & 3) + 8 * (r >> 2); if (kv > q) s0[r] = -INFINITY; if (kv + 32 > q) s1[r] = -INFINITY; } } }
                float ra = MX3(s0[0], s0[1], s1[0]), rb = MX3(s0[2], s0[3], s1[1]); ra = MX3(ra, s1[2], s1[3]);
#pragma unroll
                for (int r = 4; r < 16; r += 4) { ra = MX3(ra, s0[r], s0[r + 1]); rb = MX3(rb, s0[r + 2], s0[r + 3]); ra = MX3(ra, s1[r], s1[r + 1]); rb = MX3(rb, s1[r + 2], s1[r + 3]); }
                const float rm = swapmax(fmaxf(ra, rb)) - (FOLD ? 0.f : mhat - cq);
                const bool fst = first && m == 0;
                if (fst || __any(rm > AT_THR)) { const float dl = fst ? rm : fmaxf(rm, 0.f); mhat += dl;
                    if (FOLD) {
#pragma unroll
                        for (int r = 0; r < 16; ++r) { s0[r] -= dl; s1[r] -= dl; negm[r] = cq - mhat; } }
                    if (!fst) { const float f = exp2f(-dl);
#pragma unroll
                        for (int mm = 0; mm < NMAP; ++mm) { lsum[mm] *= f;
#pragma unroll
                            for (int r = 0; r < 16; ++r) { o[mm][0][r] *= f; o[mm][1][r] *= f; } } } }
                float sacc = 0.f; const float sh = FOLD ? 0.f : mhat - cq;
#pragma unroll
                for (int r = 0; r < 16; ++r) { s0[r] = __builtin_amdgcn_exp2f(FOLD ? s0[r] : s0[r] - sh); s1[r] = __builtin_amdgcn_exp2f(FOLD ? s1[r] : s1[r] - sh); sacc += s0[r] + s1[r]; }
                lsum[m] += sacc;
                if (pvnow) AT_VLOAD(vs, 4, 8);
#pragma unroll
                for (int i = 0; i < 4; ++i) { pw[m][0][i] = cvtpk_dep(s0[2 * i], s0[2 * i + 1], sacc); pw[m][1][i] = cvtpk_dep(s0[8 + 2 * i], s0[8 + 2 * i + 1], sacc); pw[m][2][i] = cvtpk_dep(s1[2 * i], s1[2 * i + 1], sacc); pw[m][3][i] = cvtpk_dep(s1[8 + 2 * i], s1[8 + 2 * i + 1], sacc); }
                if (pvnow) AT_PV(m, false);
            }
            if (lag) { pend = true; vprev = vs; }
        } else if (KPIPE && t + 1 == tlo_w) AT_KLOAD(ksn);
        ks = ksn; vs = (vs + 1) & 3;
    }
    if (pend) { AT_VLOAD(vprev, 0, 8); AT_PV(NMAP - 1, true); }
    float inv[NMAP];
#pragma unroll
    for (int m = 0; m < NMAP; ++m) inv[m] = 1.f / swapsum(lsum[m]);
    f32x16 res[2];
    if (TYPE == 0) { float ss = 0.f;
#pragma unroll
        for (int dh = 0; dh < 2; ++dh)
#pragma unroll
            for (int r = 0; r < 16; ++r) { const float v = o[0][dh][r] * inv[0] - lam_full * (o[NMAP - 1][dh][r] * inv[NMAP - 1]); res[dh][r] = v; ss += v * v; }
        ss = swapsum(ss); const float rs = (1.f / sqrtf(ss * (1.f / 64) + LN_EPS)) * (1.f - lam_init);
#pragma unroll
        for (int dh = 0; dh < 2; ++dh)
#pragma unroll
            for (int r = 0; r < 16; ++r) res[dh][r] = res[dh][r] * rs * dng[32 * dh + crow(r, hi)];
    } else {
#pragma unroll
        for (int dh = 0; dh < 2; ++dh)
#pragma unroll
            for (int r = 0; r < 16; ++r) res[dh][r] = o[0][dh][r] * inv[0];
    }
    bf16* orow = Odst + (size_t)q * DM;
#pragma unroll
    for (int dh = 0; dh < 2; ++dh)
#pragma unroll
        for (int g = 0; g < 4; ++g) { u32x2 w; w.x = cvtpk(res[dh][4 * g], res[dh][4 * g + 1]); w.y = cvtpk(res[dh][4 * g + 2], res[dh][4 * g + 3]); *(u32x2*)(orow + 32 * dh + 8 * g + 4 * hi) = w; }
    asm volatile("s_waitcnt lgkmcnt(0)\n\ts_barrier" ::: "memory");
#undef AT_ISSUE_K
#undef AT_ISSUE_V
#undef AT_KLOAD
#undef AT_PV
#undef AT_VLOAD
#undef AT_VF
}

struct ConvItem { const float* p0; int stride; bf16* wt; int ldk; };
__device__ __forceinline__ void conv_load(const ConvItem& it, float (&v)[64]) {
#pragma unroll
    for (int kk = 0; kk < 64; ++kk) v[kk] = it.p0[(size_t)kk * it.stride]; }
__device__ __forceinline__ void conv_store(const ConvItem& it, const float (&v)[64], LAS float* scr, int lane) {
#pragma unroll
    for (int kk = 0; kk < 64; ++kk) scr[kk * 65 + lane] = v[kk];
    asm volatile("s_waitcnt lgkmcnt(0)" ::: "memory");
    const int c = lane & 7;
#pragma unroll
    for (int j = 0; j < 8; ++j) { const int n = (lane >> 3) + 8 * j; const LAS float* s = scr + (8 * c) * 65 + n;
        u32x4 o; o.x = pk2(s[0 * 65], s[1 * 65]); o.y = pk2(s[2 * 65], s[3 * 65]); o.z = pk2(s[4 * 65], s[5 * 65]); o.w = pk2(s[6 * 65], s[7 * 65]);
        *(u32x4*)(it.wt + (size_t)n * it.ldk + 8 * c) = o; }
    asm volatile("s_waitcnt lgkmcnt(0)" ::: "memory");
}
__device__ __forceinline__ void ph_conv_experts(const Args& A, const Ctx& C0, int l) { const Ctx C = fresh(C0);
    LAS float* scr = (LAS float*)(C.lds + C.wave * CONV_SCR);
    const float* W1b = A.in[23] + (size_t)l * NEXP * DM * DEXP; const float* W2b = A.in[25] + (size_t)l * NEXP * DEXP * DM;
    const long long d31 = (const char*)(A.in[24] + (size_t)l * NEXP * DM * DEXP) - (const char*)W1b;
    bf16* wexp = WSP(bf16, WS_WEXP); const int lane = C.lane;
    auto make = [=](int g) -> ConvItem { const int e = g / 384, r = g % 384; bf16* wb = wexp + (size_t)e * 3 * DM * DEXP; ConvItem it;
        if (r < 256) { const int n0 = (r >> 4) * 64, k0 = (r & 15) * 64, n = n0 + lane; const long long o = (n & 128) ? d31 : 0ll;
            it.p0 = (const float*)((const char*)(W1b + (size_t)e * DM * DEXP) + o) + (size_t)k0 * DEXP + (n >> 8) * 128 + (n & 127); it.stride = DEXP; it.wt = wb + (size_t)n0 * DM + k0; it.ldk = DM; }
        else { const int r2 = r - 256, n0 = (r2 >> 3) * 64, k0 = (r2 & 7) * 64;
            it.p0 = W2b + (size_t)e * DEXP * DM + (size_t)k0 * DM + n0 + lane; it.stride = DM; it.wt = wb + (size_t)2 * DM * DEXP + (size_t)n0 * DEXP + k0; it.ldk = DEXP; }
        return it; };
    const int total = NEXP * 384, st = C.ngw; float va[64], vb[64];
    int g = C.gw; if (g >= total) return;
    ConvItem ia = make(g), ib = ia; conv_load(ia, va);
    for (; g < total; g += 2 * st) {
        const bool hb_ = g + st < total, ha_ = g + 2 * st < total;
        if (hb_) { ib = make(g + st); conv_load(ib, vb); }
        conv_store(ia, va, scr, lane);
        if (ha_) { ia = make(g + 2 * st); conv_load(ia, va); }
        if (hb_) conv_store(ib, vb, scr, lane);
    }
}
__device__ __forceinline__ void ph_attn(const Args& A, const Ctx& C0, int l) { const Ctx C = fresh(C0);
    const bf16* proj = WSP(bf16, WS_R1); const bf16* mq = WSP(bf16, WS_R2); const bf16* mk = WSP(bf16, WS_R2 + 24 * MiB); const bf16* mv = WSP(bf16, WS_R2 + 48 * MiB);
    const float* cumT = WSP(float, WS_MISC + MO_CUM); const float* btab = WSP(float, WS_MISC + MO_T5) + (size_t)l * 2 * 4 * 320; bf16* O = WSP(bf16, WS_R3);
    float lam_full; const float lam_init = 0.8f - 0.6f * expf(-0.3f * (float)l);
    { const float* lm = A.in[6] + l * 128; float a = 0.f, b = 0.f; for (int i = 0; i < 32; ++i) { a += lm[i] * lm[32 + i]; b += lm[64 + i] * lm[96 + i]; } lam_full = expf(a) - expf(b) + lam_init; }
    const float* dng = A.in[7] + l * 64;
    const int vcu = (C.G % 8 == 0) ? ((int)(blockIdx.x % 8) * (C.G / 8) + (int)(blockIdx.x / 8)) : (int)blockIdx.x;
    const int conv_at = (int)(blockIdx.x & 7);
    for (int up = vcu; up < 256 + C.G; up += C.G) {
        const bool has = up < 256; const int bh = (up >> 4) & 15, j = up & 15, b = bh >> 2, h = bh & 3; const size_t rb = (size_t)b * SEQ;
        const unsigned* qkm = WSP(unsigned, WS_CTL) + CW_QKMAX + l * 32; const float bqk = sqrtf(__uint_as_float(__hip_atomic_load(qkm + bh, __ATOMIC_RELAXED, __HIP_MEMORY_SCOPE_AGENT)) * __uint_as_float(__hip_atomic_load(qkm + 16 + bh, __ATOMIC_RELAXED, __HIP_MEMORY_SCOPE_AGENT))) * 1.001f;
        for (int s8 = 0; s8 < 8; ++s8) { const int k = s8 >> 2, ty = s8 & 3, qb = k ? 31 - j : j;
            if (has) {
                if (ty == 0) { AttnSrc S{proj + rb * NPROJ + PC_DQ + h * 64, proj + rb * NPROJ + PC_DK + h * 64, proj + rb * NPROJ + PC_DV + h * 64, NPROJ, NPROJ, NPROJ};
                    attn_unit<0>(C, S, qb, btab + h * 320, nullptr, O + rb * DM + 0 * 256 + h * 64, lam_full, lam_init, dng, 0.f); }
                else if (ty == 1) { AttnSrc S{mq + rb * 384 + h * 96, mk + rb * 384 + h * 96, mv + rb * 256 + h * 64, 384, 384, 256};
                    attn_unit<2>(C, S, qb, nullptr, nullptr, O + rb * DM + 2 * 256 + h * 64, 0.f, 0.f, nullptr, 0.f); }
                else if (ty == 2) { AttnSrc S{proj + rb * NPROJ + PC_FQ + h * 64, proj + rb * NPROJ + PC_FK + h * 64, proj + rb * NPROJ + PC_FV + h * 64, NPROJ, NPROJ, NPROJ};
                    attn_unit<3>(C, S, qb, nullptr, cumT + (size_t)bh * SEQ, O + rb * DM + 3 * 256 + h * 64, 0.f, 0.f, nullptr, bqk); }
                else { AttnSrc S{proj + rb * NPROJ + PC_BQ + h * 64, proj + rb * NPROJ + PC_BK + h * 64, proj + rb * NPROJ + PC_BV + h * 64, NPROJ, NPROJ, NPROJ};
                    attn_unit<1>(C, S, qb, btab + (4 + h) * 320, nullptr, O + rb * DM + 1 * 256 + h * 64, 0.f, 0.f, nullptr, 0.f); } }
            if (up == vcu && s8 == conv_at) { ph_conv_experts(A, C, l); __syncthreads(); }
        } }
}

struct MergeSched : pg8::PlainRows { const char* hb; const char* O; const char* Wg; const char* Wb; int G, c;
    __device__ __forceinline__ bool next(int i, pg8::Unit& u) const { int reg = c + G * (i >> 3); if (reg >= (NT / 256) * 4) return false;
        if ((G & 31) == 0) { const int x = c & 7, j = c >> 3, per = G >> 5; reg = ((i >> 3) * (G >> 2) + x * per + (j >> 2)) * 4 + (j & 3); }
        const int sq = i & 7, pm = reg >> 2, pc = reg & 3; u.pm = pm; u.pn = pc; u.aux = sq;
        if (sq < 4) { u.A = O + (size_t)pm * 256 * 2048 + sq * 512; u.B = Wb + (size_t)pc * 256 * 2048 + sq * 512; u.nt = 4; }
        else { u.A = hb + (size_t)pm * 256 * 2048; u.B = Wg + (size_t)((pc * 4 + (sq - 4)) * 256) * 2048; u.nt = 16; }
        return true; } };
struct EpiMerge { unsigned char* park; const float* bg; bf16* mg;
    __device__ __forceinline__ void operator()(const f32x4 (&acc)[2][2][4][2], const pg8::Unit& u, int tid, int wr, int wc, int fr, int fq) const {
        const __amdgpu_buffer_rsrc_t rs = __builtin_amdgcn_make_buffer_rsrc(park, 0, 512 * 1024, 0x00020000);
        if (u.aux < 4) { const int vo = ((wr * 64 + fr) * 256 + wc * 32 + 8 * fq) * 2, so = u.aux * 131072;
#pragma unroll
            for (int ai = 0; ai < 2; ++ai)
#pragma unroll
                for (int m = 0; m < 4; ++m)
#pragma unroll
                    for (int bj = 0; bj < 2; ++bj) __builtin_amdgcn_raw_buffer_store_b128(pack8(acc[ai][bj][m][0], acc[ai][bj][m][1]), rs, vo, so + (ai * 128 + m * 16) * 512 + bj * 256, 0);
        } else { const int cq = u.aux - 4; const int vo = ((wr * 64 + fr) * 256 + wc * 16 + fq * 4) * 2, so = cq * 128; const int c4 = u.pn * 256 + cq * 64 + wc * 16 + fq * 4;
            f32x4 bias[4];
#pragma unroll
            for (int n = 0; n < 4; ++n) bias[n] = *(const f32x4*)(bg + n * DM + c4);
#pragma unroll
            for (int ai = 0; ai < 2; ++ai) {
                u32x2 ub[4][4];
#pragma unroll
                for (int m = 0; m < 4; ++m)
#pragma unroll
                    for (int n = 0; n < 4; ++n) ub[m][n] = __builtin_amdgcn_raw_buffer_load_b64(rs, vo, so + n * 131072 + (ai * 128 + m * 16) * 512, 16);
#pragma unroll
                for (int m = 0; m < 4; ++m) { f32x4 t = {0.f, 0.f, 0.f, 0.f};
#pragma unroll
                    for (int n = 0; n < 4; ++n) { f32x4 g = acc[ai][n >> 1][m][n & 1] + bias[n]; const u32x2 uw = ub[m][n];
#pragma unroll
                        for (int i = 0; i < 4; ++i) g[i] = __builtin_amdgcn_rcpf(1.f + __builtin_amdgcn_exp2f(-LOG2E * g[i]));
                        t += g * (f32x4){bflo(uw.x), bfhi(uw.x), bflo(uw.y), bfhi(uw.y)}; }
                    u32x2 w; w.x = cvtpk(t[0], t[1]); w.y = cvtpk(t[2], t[3]);
                    *(u32x2*)(mg + (size_t)(u.pm * 256 + ai * 128 + wr * 64 + m * 16 + fr) * DM + c4) = w; } } } }
};
__device__ __forceinline__ void ph_merge(const Args& A, const Ctx& C0, int l) { const Ctx C = fresh(C0);
    MergeSched S; S.hb = (const char*)WSP(bf16, WS_HB); S.O = (const char*)WSP(bf16, WS_R3); S.Wg = (const char*)WSP(bf16, WS_WSM + l * WSM_STRIDE + WO_WG); S.Wb = (const char*)WSP(bf16, WS_WSM + l * WSM_STRIDE + WO_WB); S.G = C.G; S.c = blockIdx.x;
    unsigned char* park = C.ws + WS_R1 + (size_t)blockIdx.x * (512 * 1024);
    EpiMerge E{park, A.in[14] + (size_t)l * 4 * DM, WSP(bf16, WS_R2)};
    pg8::gemm_phase<false>(C.lds, C.tid, DM * 2, DM * 2, S, E);
}

__device__ __forceinline__ void ph_out(const Ctx& C0, int l) { const Ctx C = fresh(C0);
    GridSched S; S.A = (const char*)WSP(bf16, WS_R2); S.B = (const char*)WSP(bf16, WS_WSM + l * WSM_STRIDE + WO_WO); S.nM = NT / 256; S.nN = DM / 256; S.nt = DM / 64; S.G = C.G; S.c = blockIdx.x; S.lda = DM * 2; S.ldb = DM * 2;
    EpiStoreBf16 E{WSP(bf16, WS_R1), DM};
    pg8::gemm_phase<false>(C.lds, C.tid, DM * 2, DM * 2, S, E);
}

__device__ __forceinline__ void ph_ln1_route(const Args& A, const Ctx& C0, int l, bool dry = false) { const Ctx C = fresh(C0);
    const bf16* y1 = WSP(bf16, WS_R1); bf16* hb = WSP(bf16, WS_HB); bf16* hbo = dry ? WSP(bf16, WS_R3) : hb;
    const float* g = A.in[17] + l * DM; const float* bb = A.in[18] + l * DM;
    const float* wrt = WSP(float, WS_MISC + MO_WRT) + (size_t)l * 36 * DM; const float* bgr = A.in[20] + l * 4; const float* be = A.in[22] + l * 32;
    float* gatev = WSP(float, WS_MISC + MO_GATE); int* list = WSP(int, WS_MISC + MO_LIST); unsigned* cnt = WSP(unsigned, WS_CTL) + CW_CNT + l * 32;
    LAS float* wel = (LAS float*)C.lds;
    LAS unsigned* lcnt = (LAS unsigned*)(C.lds + LDS_TAB); LAS unsigned* lbase = lcnt + 32;
    __syncthreads();
    for (int i = C.tid; i < 32 * DM / 4; i += NTHR) ((LAS f32x4*)wel)[i] = ((const f32x4*)(wrt + 4 * DM))[i];
    f32x4 wgr[4][4];
#pragma unroll
    for (int e = 0; e < 4; ++e)
#pragma unroll
        for (int j = 0; j < 4; ++j) wgr[e][j] = *(const f32x4*)(wrt + e * DM + 8 * C.lane + 512 * (j >> 1) + 4 * (j & 1));
    for (int blk = blockIdx.x; blk < NT / 128; blk += C.G) {
        if (C.tid < 32) lcnt[C.tid] = 0u;
        __syncthreads();
        int my_ea = 0, my_eb = 0; float my_ga = 0.f, my_gb = 0.f;
        f32x4 vn[4];
#pragma unroll
        for (int j = 0; j < 2; ++j) { const size_t o = (size_t)(blk * 128 + C.wave * 16) * DM + 8 * C.lane + 512 * j; f32x4 h0, h1, y0, y1v; ld8bf(hb + o, h0, h1); ld8bf(y1 + o, y0, y1v); vn[2 * j] = h0 * DN_ALPHA + y0; vn[2 * j + 1] = h1 * DN_ALPHA + y1v; }
        for (int r = 0; r < 16; ++r) { const int m = blk * 128 + C.wave * 16 + r; f32x4 v[4];
#pragma unroll
            for (int j = 0; j < 4; ++j) v[j] = vn[j];
            if (r + 1 < 16) {
#pragma unroll
                for (int j = 0; j < 2; ++j) { const size_t o = (size_t)(m + 1) * DM + 8 * C.lane + 512 * j; f32x4 h0, h1, y0, y1v; ld8bf(hb + o, h0, h1); ld8bf(y1 + o, y0, y1v); vn[2 * j] = h0 * DN_ALPHA + y0; vn[2 * j + 1] = h1 * DN_ALPHA + y1v; } }
            ln_row(v, g, bb, nullptr, hbo + (size_t)m * DM, C.lane);
            float gg[4];
#pragma unroll
            for (int e = 0; e < 4; ++e) { float p = 0.f;
#pragma unroll
                for (int j = 0; j < 4; ++j) p += (v[j].x * wgr[e][j].x + v[j].y * wgr[e][j].y) + (v[j].z * wgr[e][j].z + v[j].w * wgr[e][j].w);
                gg[e] = wave_sum_l(p, C.lane) + bgr[e]; }
            int gi = 0; float gm = gg[0];
#pragma unroll
            for (int i = 1; i < 4; ++i) if (gg[i] > gm) { gm = gg[i]; gi = i; }
            float gs = 0.f;
#pragma unroll
            for (int i = 0; i < 4; ++i) gs += expf(gg[i] - gm);
            const float g_val = 1.f / gs;
            gi = __builtin_amdgcn_readfirstlane(gi);
            float el[8];
#pragma unroll
            for (int e = 0; e < 8; ++e) { const LAS float* wr = wel + (gi * 8 + e) * DM + 8 * C.lane; float p = 0.f;
#pragma unroll
                for (int j = 0; j < 4; ++j) { const f32x4 w = *(const LAS f32x4*)(wr + 512 * (j >> 1) + 4 * (j & 1)); p += (v[j].x * w.x + v[j].y * w.y) + (v[j].z * w.z + v[j].w * w.w); }
                el[e] = wave_sum_l(p, C.lane) + be[gi * 8 + e]; }
            int i1 = 0; float m1 = el[0];
#pragma unroll
            for (int i = 1; i < 8; ++i) if (el[i] > m1) { m1 = el[i]; i1 = i; }
            int i2 = -1; float m2 = -1e30f;
#pragma unroll
            for (int i = 0; i < 8; ++i) if (i != i1 && el[i] > m2) { m2 = el[i]; i2 = i; }
            const float p2 = expf(m2 - m1); const float ga = g_val / (1.f + p2), gb = g_val * p2 / (1.f + p2);
            if (C.lane == r) { my_ea = gi * 8 + i1; my_eb = gi * 8 + i2; my_ga = ga; my_gb = gb; } }
        unsigned ia = 0u, ib = 0u;
        if (dry) continue;
        if (C.lane < 16) { ia = __hip_atomic_fetch_add(lcnt + my_ea, 1u, __ATOMIC_RELAXED, __HIP_MEMORY_SCOPE_WORKGROUP); ib = __hip_atomic_fetch_add(lcnt + my_eb, 1u, __ATOMIC_RELAXED, __HIP_MEMORY_SCOPE_WORKGROUP); }
        __syncthreads();
        if (C.tid < 32) lbase[C.tid] = atomicAdd(cnt + C.tid, lcnt[C.tid]);
        __syncthreads();
        if (C.lane < 16) { const int m = blk * 128 + C.wave * 16 + C.lane;
            gatev[2 * m] = my_ga; gatev[2 * m + 1] = my_gb;
            list[(size_t)my_ea * NSLOT + lbase[my_ea] + ia] = 2 * m; list[(size_t)my_eb * NSLOT + lbase[my_eb] + ib] = 2 * m + 1; }
        __syncthreads();
    }
}

__device__ __forceinline__ void moe_tables(const Ctx& C, int l, LAS int* tb, LAS int* cn) {
    const unsigned* cnt = WSP(unsigned, WS_CTL) + CW_CNT + l * 32;
    __syncthreads();
    if (C.tid == 0) { int t = 0; for (int e = 0; e < NEXP; ++e) { const int c = (int)__hip_atomic_load(cnt + e, __ATOMIC_RELAXED, __HIP_MEMORY_SCOPE_AGENT); cn[e] = c; tb[e] = t; t += (c + 255) / 256; } tb[NEXP] = t; }
    __syncthreads();
}
struct MoeSched { const char* hb; const char* hbuf; const char* wexp; const int* list; LAS int* tb; LAS int* cn; int G, c, up;
    __device__ __forceinline__ bool next(int i, pg8::Unit& u) const { const int cx = (G & 7) == 0 ? (c & 7) * (G >> 3) + (c >> 3) : c;
        const int L = i * G + cx; if (L >= tb[NEXP] * 4) return false;
        const int tg = L >> 2, pn = L & 3; int e = 0; while (tb[e + 1] <= tg) ++e;
        u.pm = tg; u.pn = pn; u.aux = e | ((tg - tb[e]) << 8);
        if (up) { u.A = hb; u.B = wexp + (size_t)e * 3 * DM * DEXP * 2 + (size_t)pn * 256 * 2048; u.nt = 16; }
        else { u.A = hbuf + (size_t)tg * 256 * (DEXP * 2); u.B = wexp + (size_t)e * 3 * DM * DEXP * 2 + (size_t)2 * DM * DEXP * 2 + (size_t)pn * 256 * (DEXP * 2); u.nt = 8; }
        return true; }
    __device__ __forceinline__ void a_rows(const pg8::Unit& u, const int (&RA)[2], const int (&CA2)[2], int lda, unsigned (&va)[2][2]) const {
        const int e = u.aux & 255, ti = u.aux >> 8, c_e = cn[e];
#pragma unroll
        for (int h = 0; h < 2; ++h)
#pragma unroll
            for (int i = 0; i < 2; ++i) { const int r = h * 128 + RA[i];
                if (up) { const int rr = ti * 256 + r; const int tok = rr < c_e ? (list[(size_t)e * NSLOT + rr] >> 1) : 0; va[h][i] = (unsigned)tok * 2048u + (unsigned)CA2[i]; }
                else va[h][i] = (unsigned)(r * lda + CA2[i]); } }
};
struct EpiExpUp { bf16* hbuf;
    __device__ __forceinline__ void operator()(const f32x4 (&acc)[2][2][4][2], const pg8::Unit& u, int tid, int wr, int wc, int fr, int fq) const {
        const int row0 = u.pm * 256 + wr * 64 + fr, col0 = u.pn * 128 + wc * 32 + 8 * fq;
#pragma unroll
        for (int ai = 0; ai < 2; ++ai)
#pragma unroll
            for (int m = 0; m < 4; ++m) { f32x4 h0, h1;
#pragma unroll
                for (int i = 0; i < 4; ++i) { const float a0 = acc[ai][0][m][0][i], a1 = acc[ai][0][m][1][i];
                    h0[i] = a0 * __builtin_amdgcn_rcpf(1.f + __builtin_amdgcn_exp2f(-LOG2E * a0)) * acc[ai][1][m][0][i]; h1[i] = a1 * __builtin_amdgcn_rcpf(1.f + __builtin_amdgcn_exp2f(-LOG2E * a1)) * acc[ai][1][m][1][i]; }
                *(u32x4*)(hbuf + (size_t)(row0 + ai * 128 + m * 16) * DEXP + col0) = pack8(h0, h1); } }
};
struct EpiExpDown { bf16* ys; const int* list; const float* gatev; int* inv; LAS int* cn;
    __device__ __forceinline__ void operator()(const f32x4 (&acc)[2][2][4][2], const pg8::Unit& u, int tid, int wr, int wc, int fr, int fq) const {
        const int e = u.aux & 255, ti = u.aux >> 8, c_e = cn[e]; const int col0 = u.pn * 256 + wc * 32 + 8 * fq;
#pragma unroll
        for (int ai = 0; ai < 2; ++ai)
#pragma unroll
            for (int m = 0; m < 4; ++m) { const int rl = ai * 128 + wr * 64 + m * 16 + fr, rr = ti * 256 + rl;
                if (rr < c_e) { const int slot = list[(size_t)e * NSLOT + rr]; const float g = gatev[slot]; const size_t dest = (size_t)u.pm * 256 + rl;
#pragma unroll
                    for (int bj = 0; bj < 2; ++bj) *(u32x4*)(ys + dest * DM + col0 + bj * 128) = pack8(acc[ai][bj][m][0] * g, acc[ai][bj][m][1] * g);
                    if (u.pn == 0 && wc == 0 && fq == 0) inv[slot] = (int)dest; } } }
};
__device__ __forceinline__ void ph_exp_up(const Ctx& C0, int l) { const Ctx C = fresh(C0);
    LAS int* tb = (LAS int*)(C.lds + LDS_TAB); LAS int* cn = tb + 64;
    moe_tables(C, l, tb, cn);
    MoeSched S; S.hb = (const char*)WSP(bf16, WS_HB); S.hbuf = (const char*)WSP(bf16, WS_R3); S.wexp = (const char*)WSP(bf16, WS_WEXP); S.list = WSP(int, WS_MISC + MO_LIST); S.tb = tb; S.cn = cn; S.G = C.G; S.c = blockIdx.x; S.up = 1;
    EpiExpUp E{WSP(bf16, WS_R3)};
    pg8::gemm_phase<true>(C.lds, C.tid, DM * 2, DM * 2, S, E);
}
__device__ __forceinline__ void ph_exp_down(const Ctx& C0, int l) { const Ctx C = fresh(C0);
    LAS int* tb = (LAS int*)(C.lds + LDS_TAB); LAS int* cn = tb + 64;
    moe_tables(C, l, tb, cn);
    MoeSched S; S.hb = (const char*)WSP(bf16, WS_HB); S.hbuf = (const char*)WSP(bf16, WS_R3); S.wexp = (const char*)WSP(bf16, WS_WEXP); S.list = WSP(int, WS_MISC + MO_LIST); S.tb = tb; S.cn = cn; S.G = C.G; S.c = blockIdx.x; S.up = 0;
    EpiExpDown E{WSP(bf16, WS_R1), WSP(int, WS_MISC + MO_LIST), WSP(float, WS_MISC + MO_GATE), WSP(int, WS_MISC + MO_INV), cn};
    pg8::gemm_phase<false>(C.lds, C.tid, DEXP * 2, DEXP * 2, S, E);
}
__device__ __forceinline__ void ph_combine(const Args& A, const Ctx& C0, int l, bool dry = false) { const Ctx C = fresh(C0);
    const int* inv = WSP(int, WS_MISC + MO_INV); const bf16* ys = WSP(bf16, WS_R1); bf16* hb = WSP(bf16, WS_HB); bf16* hbo = dry ? WSP(bf16, WS_R3) : hb;
    const float* g = A.in[26] + l * DM; const float* bb = A.in[27] + l * DM;
    for (int m = 2 * C.gw; m < NT; m += 2 * C.ngw) {
        const int4 iv = *(const int4*)(inv + 2 * m); f32x4 v[2][4];
#pragma unroll
        for (int r = 0; r < 2; ++r) { const size_t d0 = (size_t)(r ? iv.z : iv.x), d1 = (size_t)(r ? iv.w : iv.y);
#pragma unroll
            for (int j = 0; j < 2; ++j) { const int c = 8 * C.lane + 512 * j; f32x4 h0, h1, a0, a1, b0, b1;
                ld8bf(hb + (size_t)(m + r) * DM + c, h0, h1); ld8bf(ys + d0 * DM + c, a0, a1); ld8bf(ys + d1 * DM + c, b0, b1);
                v[r][2 * j] = h0 * DN_ALPHA + a0 + b0; v[r][2 * j + 1] = h1 * DN_ALPHA + a1 + b1; } }
#pragma unroll
        for (int r = 0; r < 2; ++r) ln_row(v[r], g, bb, (l == NL - 1 && !dry) ? C.hf + (size_t)(m + r) * DM : nullptr, hbo + (size_t)(m + r) * DM, C.lane); }
}

__global__ void __launch_bounds__(NTHR, 2) fwd(Args args) {
    extern __shared__ __attribute__((aligned(16))) unsigned char lds_raw[];
    Ctx C;
    C.hf = args.out; C.ws = args.ws; C.lds = (LAS unsigned char*)lds_raw;
    C.tid = threadIdx.x; C.lane = C.tid & 63; C.wave = __builtin_amdgcn_readfirstlane(C.tid >> 6); C.G = gridDim.x;
    C.gw = blockIdx.x * NWAVES + C.wave; C.ngw = C.G * NWAVES;
    for (int u = C.tid; u < (LDS_BYTES - LDS_MISC) / 4; u += NTHR) ((LAS unsigned*)(C.lds + LDS_MISC))[u] = 0u;
    __syncthreads();
    XcdBarrier bar = xcd_barrier_post(WSP(unsigned, WS_CTL) + CW_BAR, (volatile LAS unsigned*)(C.lds + LDS_MISC), (unsigned)C.wave);
#define GRID_BAR() do { XcdBarrier b_ = bar; asm volatile("" : "+s"(b_.bar), "+s"(b_.x), "+s"(b_.wv)); xcd_barrier(b_); } while (0)
#define RUNPH(k, call) do { call; GRID_BAR(); if (PROBE_DUP == (k)) { call; GRID_BAR(); } } while (0)
    ph_prologue(args, C); GRID_BAR(); if (PROBE_DUP == 0) { ph_prologue(args, C); GRID_BAR(); }
    for (int l = 0; l < NL; ++l) {
        RUNPH(1, ph_proj(args, C, l));
        RUNPH(3, ph_mla_up(args, C, l));
        RUNPH(4, ph_attn(args, C, l));
        RUNPH(5, ph_merge(args, C, l));
        RUNPH(6, ph_out(C, l));
        if (PROBE_DUP == 10) { ph_ln1_route(args, C, l, true); GRID_BAR(); }
        ph_ln1_route(args, C, l); GRID_BAR();
        RUNPH(8, ph_exp_up(C, l));
        RUNPH(9, ph_exp_down(C, l));
        if (PROBE_DUP == 11) { ph_combine(args, C, l, true); GRID_BAR(); }
        ph_combine(args, C, l); if (l + 1 < NL) GRID_BAR();
    }
}

extern "C" void kernel_launch(void* const* d_in, const int* in_sizes, int n_in, void* d_out, int out_size, void* d_ws, size_t ws_size, hipStream_t stream) {
    static int grid = 0;
    if (grid == 0) {
        if (n_in != 28 || out_size != NT * DM || ws_size < WS_END) { fprintf(stderr, "kernel_launch: unexpected shapes (n_in %d out %d ws %zu)\n", n_in, out_size, ws_size); grid = -1; return; }
        int dev = 0, cus = 0, per_cu = 0;
        if (hipGetDevice(&dev) != hipSuccess || hipDeviceGetAttribute(&cus, hipDeviceAttributeMultiprocessorCount, dev) != hipSuccess) { grid = -1; return; }
        if (hipFuncSetAttribute((const void*)fwd, hipFuncAttributeMaxDynamicSharedMemorySize, LDS_BYTES) != hipSuccess) { grid = -1; return; }
        if (hipOccupancyMaxActiveBlocksPerMultiprocessor(&per_cu, (const void*)fwd, NTHR, LDS_BYTES) != hipSuccess || per_cu < 1) { fprintf(stderr, "kernel_launch: occupancy query says %d blocks per CU\n", per_cu); (void)hipGetLastError(); grid = -1; return; }
        grid = cus;
    }
    if (grid < 0) return;
    (void)hipMemsetAsync((char*)d_ws + WS_CTL, 0, CTL_BYTES, stream);
    Args a{};
    for (int i = 0; i < 28; ++i) a.in[i] = (const float*)d_in[i];
    a.out = (float*)d_out; a.ws = (unsigned char*)d_ws; a.ph_lo = 0; a.ph_hi = 0;
    hipLaunchKernelGGL(fwd, dim3(grid), dim3(NTHR), LDS_BYTES, stream, a);
}
```
